# Optimizing an MI355X kernel written in HIP

```python
import jax, jax.numpy as jnp
from jax import lax
import numpy as np

D_MODEL = 2048
BATCH = 2
SEQ = 8192
DEPTH = 1
DEC_BATCH = 16
DEC_SEQ = 32
PAST_LEN = 1024

CHUNK = 64
EPS = 1e-6
VA = 128
HA = (D_MODEL // 2) // VA
NOPE = 128
ROPE = 64
QKA = NOPE + ROPE
Q_LORA = 512
KV_LORA = 256
ROPE_BASE = 10000.0
SCALE_A = QKA ** -0.5
DHB = 128
HB = (D_MODEL // 2) // DHB
BAND_CHUNKS = 8
BAND_PAST = BAND_CHUNKS * CHUNK
BAND_KEYS = (BAND_CHUNKS + 1) * CHUNK
MAX_REL = 128
N_REL = 2 * MAX_REL + 1
SCALE_B = DHB ** -0.5
MIX_WIDTH = HA * VA + HB * DHB
IN_COLS = Q_LORA + KV_LORA + ROPE + 3 * HB * DHB
SPLITS = [Q_LORA, Q_LORA + KV_LORA, Q_LORA + KV_LORA + ROPE,
          Q_LORA + KV_LORA + ROPE + HB * DHB, Q_LORA + KV_LORA + ROPE + 2 * HB * DHB]
D_FF = 4 * D_MODEL
Q_BLOCK = 128
NEG = -1e30

kernel_name = 'hybrid_mla_chunkband_stream_step'


def rms_norm(x, g):
    xf = x.astype(jnp.float32)
    y = xf * lax.rsqrt(jnp.mean(xf * xf, axis=-1, keepdims=True) + EPS)
    return (y * g.astype(jnp.float32)).astype(x.dtype)


def rope_part(x, pos):
    inv = 1.0 / (ROPE_BASE ** (jnp.arange(0, ROPE, 2, dtype=jnp.float32) / ROPE))
    ang = pos.astype(jnp.float32)[:, None] * inv[None, :]
    c = jnp.cos(ang)[:, None, :].astype(x.dtype)
    s = jnp.sin(ang)[:, None, :].astype(x.dtype)
    x1, x2 = jnp.split(x[..., NOPE:], 2, axis=-1)
    return jnp.concatenate([x[..., :NOPE], x1 * c - x2 * s, x1 * s + x2 * c], axis=-1)


def mixer_inputs(hn, pos, w_in, g_cq, w_uq, g_ckv, g_qa, g_qb, g_kb):
    B, T, _ = hn.shape
    c_q, c_kv, kpe, qb, kb, vb = jnp.split(hn @ w_in, SPLITS, axis=-1)
    qa = (rms_norm(c_q, g_cq) @ w_uq).reshape(B, T, HA, QKA)
    qa = rope_part(rms_norm(qa, g_qa), pos)
    ckv = rms_norm(c_kv, g_ckv)
    qb = rms_norm(qb.reshape(B, T, HB, DHB), g_qb)
    kb = rms_norm(kb.reshape(B, T, HB, DHB), g_kb)
    vb = vb.reshape(B, T, HB, DHB)
    return qa, ckv, kpe, qb, kb, vb


def mla_keys_values(ckv, kpe, pos, w_uk, w_uv, g_ka):
    B, T, _ = ckv.shape
    k_nope = (ckv @ w_uk).reshape(B, T, HA, NOPE)
    k = jnp.concatenate([k_nope, jnp.broadcast_to(kpe[:, :, None, :], (B, T, HA, ROPE))], axis=-1)
    k = rope_part(rms_norm(k, g_ka), pos)
    v = (ckv @ w_uv).reshape(B, T, HA, VA)
    return k, v


def dense_attention(q, k, v, scale, bias):
    B, Q = q.shape[:2]
    s = jnp.einsum('bqhd,bkhd->bhqk', q, k, preferred_element_type=jnp.float32) * scale
    if bias is not None:
        s = s + bias.astype(jnp.float32)[None]
    p = jax.nn.softmax(s, axis=-1).astype(v.dtype)
    return jnp.einsum('bhqk,bkhd->bqhd', p, v).reshape(B, Q, -1)


def mla_prompt(q, k, v):
    B, S = q.shape[:2]
    nblk = S // Q_BLOCK
    qblocks = q.reshape(B, nblk, Q_BLOCK, HA, QKA).transpose(1, 0, 2, 3, 4)
    key_chunk = jnp.arange(S) // CHUNK

    def one_block(args):
        qblk, i = args
        q_chunk = (i * Q_BLOCK + jnp.arange(Q_BLOCK)) // CHUNK
        s = jnp.einsum('bqhd,bkhd->bhqk', qblk, k, preferred_element_type=jnp.float32) * SCALE_A
        s = jnp.where((key_chunk[None, :] <= q_chunk[:, None])[None, None], s, NEG)
        p = jax.nn.softmax(s, axis=-1).astype(v.dtype)
        return jnp.einsum('bhqk,bkhd->bqhd', p, v)

    o = lax.map(one_block, (qblocks, jnp.arange(nblk)))
    return o.transpose(1, 0, 2, 3, 4).reshape(B, S, HA * VA)


def band_prompt(q, k, v, rel_bias):
    B, S = q.shape[:2]
    NC = S // CHUNK
    qc = q.reshape(B, NC, CHUNK, HB, DHB)
    pad = ((0, 0), (BAND_CHUNKS, 0), (0, 0), (0, 0), (0, 0))
    kc = jnp.pad(k.reshape(B, NC, CHUNK, HB, DHB), pad)
    vc = jnp.pad(v.reshape(B, NC, CHUNK, HB, DHB), pad)
    kband = jnp.concatenate([kc[:, j:j + NC] for j in range(BAND_CHUNKS + 1)], axis=2)
    vband = jnp.concatenate([vc[:, j:j + NC] for j in range(BAND_CHUNKS + 1)], axis=2)
    src_chunk = jnp.arange(NC)[:, None] - BAND_CHUNKS + jnp.arange(BAND_CHUNKS + 1)[None, :]
    valid = jnp.repeat(src_chunk >= 0, CHUNK, axis=1)
    rel = jnp.arange(CHUNK)[:, None] - (jnp.arange(BAND_KEYS) - BAND_PAST)[None, :]
    bias = rel_bias[:, jnp.clip(rel, -MAX_REL, MAX_REL) + MAX_REL].astype(jnp.float32)
    s = jnp.einsum('bcqhd,bckhd->bchqk', qc, kband, preferred_element_type=jnp.float32) * SCALE_B
    s = jnp.where(valid[None, :, None, None, :], s + bias[None, None], NEG)
    p = jax.nn.softmax(s, axis=-1).astype(v.dtype)
    o = jnp.einsum('bchqk,bckhd->bcqhd', p, vband)
    return o.reshape(B, S, HB * DHB)


def merge_and_ffn(h, oa, ob, w_o, norm_ffn, w_up, w_down):
    h = h + jnp.concatenate([oa, ob], axis=-1) @ w_o
    u = rms_norm(h, norm_ffn) @ w_up
    return h + jnp.square(jax.nn.relu(u)) @ w_down


def setup_inputs(seed: int = 0) -> dict:
    key = jax.random.key(seed)
    ks = jax.random.split(key, 24)
    f32 = jnp.float32
    L_band = min(BAND_PAST, PAST_LEN)

    def w(k, shape, fan_in):
        return jax.random.normal(k, (DEPTH,) + shape, f32) * (fan_in ** -0.5)

    def gain(k, n):
        return 1.0 + 0.01 * jax.random.normal(k, (DEPTH, n), f32)

    return {
        'x_prompt': jax.random.normal(ks[0], (BATCH, SEQ, D_MODEL), f32),
        'x_sample': jax.random.normal(ks[1], (DEC_BATCH, DEC_SEQ, D_MODEL), f32),
        'cache_mla_ckv': jax.random.normal(ks[2], (DEPTH, DEC_BATCH, PAST_LEN, KV_LORA), f32),
        'cache_mla_kpe': jax.random.normal(ks[3], (DEPTH, DEC_BATCH, PAST_LEN, ROPE), f32),
        'cache_band_k': jax.random.normal(ks[4], (DEPTH, DEC_BATCH, L_band, HB, DHB), f32),
        'cache_band_v': jax.random.normal(ks[5], (DEPTH, DEC_BATCH, L_band, HB, DHB), f32),
        'norm_mix': gain(ks[6], D_MODEL),
        'w_in': w(ks[7], (D_MODEL, IN_COLS), D_MODEL),
        'g_cq': gain(ks[8], Q_LORA),
        'w_uq': w(ks[9], (Q_LORA, HA * QKA), Q_LORA),
        'g_ckv': gain(ks[10], KV_LORA),
        'w_uk': w(ks[11], (KV_LORA, HA * NOPE), KV_LORA),
        'w_uv': w(ks[12], (KV_LORA, HA * VA), KV_LORA),
        'g_qa': gain(ks[13], QKA),
        'g_ka': gain(ks[14], QKA),
        'g_qb': gain(ks[15], DHB),
        'g_kb': gain(ks[16], DHB),
        'rel_bias': 0.5 * jax.random.normal(ks[17], (DEPTH, HB, N_REL), f32),
        'w_o': w(ks[18], (MIX_WIDTH, D_MODEL), MIX_WIDTH),
        'norm_ffn': gain(ks[19], D_MODEL),
        'w_up': w(ks[20], (D_MODEL, D_FF), D_MODEL),
        'w_down': w(ks[21], (D_FF, D_MODEL), D_FF),
    }


def reference(x_prompt, x_sample, cache_mla_ckv, cache_mla_kpe, cache_band_k, cache_band_v,
              norm_mix, w_in, g_cq, w_uq, g_ckv, w_uk, w_uv, g_qa, g_ka, g_qb, g_kb, rel_bias,
              w_o, norm_ffn, w_up, w_down):
    S = x_prompt.shape[1]
    T = x_sample.shape[1]
    P = cache_mla_ckv.shape[2]
    Lb = cache_band_k.shape[2]
    keep_p = min(BAND_PAST, S)
    pos_p = jnp.arange(S, dtype=jnp.int32)
    pos_s = P + jnp.arange(T, dtype=jnp.int32)
    pos_hist = jnp.arange(P + T, dtype=jnp.int32)
    band_kpos = jnp.concatenate([jnp.arange(P - Lb, P, dtype=jnp.int32), pos_s])
    band_rel = jnp.clip(pos_s[:, None] - band_kpos[None, :], -MAX_REL, MAX_REL) + MAX_REL

    hp, hs = x_prompt, x_sample
    ckv_p_l, kpe_p_l, bk_p_l, bv_p_l = [], [], [], []
    ckv_s_l, kpe_s_l, bk_s_l, bv_s_l = [], [], [], []
    for l in range(DEPTH):
        qa, ckv, kpe, qb, kb, vb = mixer_inputs(rms_norm(hp, norm_mix[l]), pos_p, w_in[l], g_cq[l],
                                                w_uq[l], g_ckv[l], g_qa[l], g_qb[l], g_kb[l])
        ka, va = mla_keys_values(ckv, kpe, pos_p, w_uk[l], w_uv[l], g_ka[l])
        oa = mla_prompt(qa, ka, va)
        ob = band_prompt(qb, kb, vb, rel_bias[l])
        hp = merge_and_ffn(hp, oa, ob, w_o[l], norm_ffn[l], w_up[l], w_down[l])
        ckv_p_l.append(ckv)
        kpe_p_l.append(kpe)
        bk_p_l.append(kb[:, S - keep_p:])
        bv_p_l.append(vb[:, S - keep_p:])

        qa_s, ckv_s, kpe_s, qb_s, kb_s, vb_s = mixer_inputs(rms_norm(hs, norm_mix[l]), pos_s, w_in[l], g_cq[l],
                                                            w_uq[l], g_ckv[l], g_qa[l], g_qb[l], g_kb[l])
        ckv_all = jnp.concatenate([cache_mla_ckv[l].astype(ckv_s.dtype), ckv_s], axis=1)
        kpe_all = jnp.concatenate([cache_mla_kpe[l].astype(kpe_s.dtype), kpe_s], axis=1)
        ka_s, va_s = mla_keys_values(ckv_all, kpe_all, pos_hist, w_uk[l], w_uv[l], g_ka[l])
        oa_s = dense_attention(qa_s, ka_s, va_s, SCALE_A, None)
        kb_all = jnp.concatenate([cache_band_k[l].astype(kb_s.dtype), kb_s], axis=1)
        vb_all = jnp.concatenate([cache_band_v[l].astype(vb_s.dtype), vb_s], axis=1)
        ob_s = dense_attention(qb_s, kb_all, vb_all, SCALE_B, rel_bias[l][:, band_rel])
        hs = merge_and_ffn(hs, oa_s, ob_s, w_o[l], norm_ffn[l], w_up[l], w_down[l])
        ckv_s_l.append(ckv_s)
        kpe_s_l.append(kpe_s)
        bk_s_l.append(kb_s)
        bv_s_l.append(vb_s)

    ckv_prompt = jnp.stack(ckv_p_l)
    kpe_prompt = jnp.stack(kpe_p_l)
    bandk_prompt = jnp.stack(bk_p_l)
    bandv_prompt = jnp.stack(bv_p_l)
    ckv_sample = jnp.stack(ckv_s_l)
    kpe_sample = jnp.stack(kpe_s_l)
    bandk_sample = jnp.stack(bk_s_l)
    bandv_sample = jnp.stack(bv_s_l)
    return (hp, hs, ckv_prompt, kpe_prompt, bandk_prompt, bandv_prompt,
            ckv_sample, kpe_sample, bandk_sample, bandv_sample)
```

```cpp
#include <hip/hip_runtime.h>
#include <hip/hip_cooperative_groups.h>
#include <cstdio>
#include <cstdint>
namespace cg = cooperative_groups;

#define LAS __attribute__((address_space(3)))
typedef unsigned short bf16_t;
typedef short bf16x8 __attribute__((ext_vector_type(8)));
typedef short s16x4 __attribute__((ext_vector_type(4)));
typedef float f32x4 __attribute__((ext_vector_type(4)));
typedef float f32x2 __attribute__((ext_vector_type(2)));
typedef float f32x16 __attribute__((ext_vector_type(16)));
typedef unsigned u32x4 __attribute__((ext_vector_type(4)));
typedef unsigned u32x2 __attribute__((ext_vector_type(2)));
typedef __bf16 bf16x2_t __attribute__((ext_vector_type(2)));

constexpr int DM = 2048, BATCH = 2, SEQ = 8192, DECB = 16, DECS = 32, PAST = 1024;
constexpr int MP = BATCH * SEQ, MS = DECB * DECS, MT = MP + MS;
constexpr int HA = 8, NOPE = 128, ROPE = 64, QKA = 192, VA = 128, QLORA = 512, KVLORA = 256;
constexpr int HB = 8, DHB = 128, BANDL = 512, MAXREL = 128, NREL = 257;
constexpr int INC = 3904, NCP = 4096;
constexpr int DFF = 8192;
constexpr int KVLEN = PAST + DECS;
constexpr int KVROWS = MP + DECB * KVLEN;
constexpr int BLEN = BANDL + DECS;
constexpr float EPS = 1e-6f;
constexpr float LOG2E = 1.4426950408889634f;
constexpr float QS_A = 0.07216878364870322f * LOG2E;
constexpr float QS_B = 0.08838834764831845f * LOG2E;

constexpr int CC_CQ = 0, CC_CKV = 512, CC_QB = 768, CC_KB = 1792, CC_VB = 2816, CC_KPE = 3840;

constexpr size_t O_Y = 0;
constexpr size_t O_CKVP = (size_t)MT * DM;
constexpr size_t O_KPEP = O_CKVP + (size_t)MP * KVLORA;
constexpr size_t O_BKP = O_KPEP + (size_t)MP * ROPE;
constexpr size_t O_BVP = O_BKP + (size_t)BATCH * BANDL * 1024;
constexpr size_t O_CKVS = O_BVP + (size_t)BATCH * BANDL * 1024;
constexpr size_t O_KPES = O_CKVS + (size_t)MS * KVLORA;
constexpr size_t O_BKS = O_KPES + (size_t)MS * ROPE;
constexpr size_t O_BVS = O_BKS + (size_t)MS * 1024;
constexpr size_t O_END = O_BVS + (size_t)MS * 1024;
static_assert(O_END == 43155456, "output size");

constexpr size_t MiB = 1u << 20;
constexpr size_t WS_ROPE = 1 * MiB;
constexpr int PU = DFF + 64;
constexpr size_t WS_WIN = 4 * MiB;
constexpr size_t WS_WUQ = 20 * MiB;
constexpr size_t WS_WUKV = 22 * MiB;
constexpr size_t WS_WO = 24 * MiB;
constexpr size_t WS_WUP = 32 * MiB;
constexpr size_t WS_WDN = 64 * MiB;
constexpr size_t WS_XN = 97 * MiB;
constexpr size_t WS_C = 163 * MiB;
constexpr size_t WS_QRAW = 163 * MiB;
constexpr size_t WS_KNRAW = 213 * MiB;
constexpr size_t WS_AO = 163 * MiB;
constexpr size_t WS_U = 163 * MiB;
constexpr size_t WS_QB = 295 * MiB;
constexpr size_t WS_KBP = 328 * MiB;
constexpr size_t WS_KBS = 360 * MiB;
constexpr size_t WS_VBP = 378 * MiB;
constexpr size_t WS_VBS = 410 * MiB;
constexpr size_t WS_CKV = 428 * MiB;
constexpr size_t WS_Q = 445 * MiB;
constexpr size_t WS_SSP = 4 * MiB;
constexpr size_t WS_AOS = 8 * MiB;
constexpr size_t WS_PCQ = 3 * MiB;
constexpr size_t WS_SLAB1 = 295 * MiB;
constexpr size_t WS_SLAB4 = 230 * MiB;
constexpr size_t WS_HB = 430 * MiB;
constexpr size_t WS_SLAB = 97 * MiB;
constexpr size_t WS_NEED = 497 * MiB;
static_assert(WS_U + (size_t)MT * PU * 2 <= WS_HB && WS_WDN + (size_t)DM * PU * 2 <= WS_XN, "map");
constexpr int CP = 640;
constexpr size_t OS_C2 = 0;
constexpr size_t OS_R = 21 * MiB;
constexpr size_t OS_SSPE = 30 * MiB;
constexpr size_t OS_K = 31 * MiB;

__device__ __forceinline__ unsigned cvtpk(float lo, float hi) { f32x2 v = {lo, hi}; bf16x2_t b = __builtin_convertvector(v, bf16x2_t); return __builtin_bit_cast(unsigned, b); }
__device__ __forceinline__ float bflo(unsigned w) { return __uint_as_float(w << 16); }
__device__ __forceinline__ float bfhi(unsigned w) { return __uint_as_float(w & 0xffff0000u); }
__device__ __forceinline__ void unpack8(u32x4 w, float* v) { v[0] = bflo(w.x); v[1] = bfhi(w.x); v[2] = bflo(w.y); v[3] = bfhi(w.y); v[4] = bflo(w.z); v[5] = bfhi(w.z); v[6] = bflo(w.w); v[7] = bfhi(w.w); }
__device__ __forceinline__ u32x4 pack8(const float* v) { u32x4 w; w.x = cvtpk(v[0], v[1]); w.y = cvtpk(v[2], v[3]); w.z = cvtpk(v[4], v[5]); w.w = cvtpk(v[6], v[7]); return w; }
__device__ __forceinline__ float red8(float v) { v += __shfl_xor(v, 1); v += __shfl_xor(v, 2); v += __shfl_xor(v, 4); return v; }
__device__ __forceinline__ float red16(float v) { v = red8(v); v += __shfl_xor(v, 8); return v; }
__device__ __forceinline__ float red64(float v) { v = red16(v); v += __shfl_xor(v, 16); v += __shfl_xor(v, 32); return v; }
#define LDS_WAIT() asm volatile("s_waitcnt lgkmcnt(0)" ::: "memory")
__device__ __forceinline__ void ld8f(const float* p, float* g) { const f32x4 a = *(const f32x4*)p, b = *(const f32x4*)(p + 4); g[0] = a[0]; g[1] = a[1]; g[2] = a[2]; g[3] = a[3]; g[4] = b[0]; g[5] = b[1]; g[6] = b[2]; g[7] = b[3]; }
__device__ __forceinline__ int lane_now() { int l; asm volatile("v_mbcnt_lo_u32_b32 %0, -1, 0\n\tv_mbcnt_hi_u32_b32 %0, -1, %0" : "=v"(l)); return l; }

namespace pg8 {
constexpr int BM = 256, BK = 64, HALF = 128, HTB = HALF * BK * 2, STAGE_BYTES = 8 * HTB, NXCD = 8, WGM = 8;
__host__ __device__ __forceinline__ int lds_byte(int r, int c) { const int st = (r >> 4) * 2 + (c >> 5), rr = r & 15, cc = c & 31, ob = rr * 64 + cc * 2; return st * 1024 + (ob ^ (((ob >> 9) & 1) << 5)); }
__host__ __device__ __forceinline__ void stage_rc(int b, int& R, int& C) { const int st = b / 1024, sb = b % 1024, swz = sb ^ (((sb >> 9) & 1) << 5); R = (st >> 1) * 16 + swz / 64; C = (st & 1) * 32 + (swz % 64) / 2; }
__host__ __device__ __forceinline__ int perm32(int rho) { const int n = rho >> 4, i = rho & 15; return 8 * (i >> 2) + 4 * n + (i & 3); }

struct Unit { int pm, pn; };
struct Gemm { const bf16_t* A; const bf16_t* Bt; int M, N, K, lda, ldb; };

struct StaticOrder {
    int nM, nN, nwg, G, c;
    __device__ void init(int M, int N, int G_, int c_) { nM = M / BM; nN = N / BM; nwg = nM * nN; G = G_; c = c_; }
    __device__ bool next(int i, Unit& u) const {
        const long L = (long)i * G + c; if (L >= nwg) return false;
        int wgid = (int)L; { const int q = nwg / NXCD, r = nwg % NXCD, xcd = wgid % NXCD, off = wgid / NXCD; wgid = (xcd < r ? xcd * (q + 1) : r * (q + 1) + (xcd - r) * q) + off; }
        const int nig = WGM * nN, gid = wgid / nig, fm = gid * WGM, gsz = (nM - fm) < WGM ? (nM - fm) : WGM;
        u.pm = fm + ((wgid % nig) % gsz); u.pn = (wgid % nig) / gsz; return true;
    }
};

template <int ACT  > struct EpiBf16 {
    static constexpr bool PERM = true;
    bf16_t* O; int ldc; int split_cols; long split_stride;
    __device__ __forceinline__ void operator()(const f32x4 (&acc)[2][2][4][2], const Unit& u, int wr, int wc, int fr, int fq) const {
        const int row0 = u.pm * BM + wr * 64 + fr; int colt = u.pn * BM; bf16_t* base = O;
        if (split_cols) { const int t = colt / split_cols; base += (long)t * split_stride; colt -= t * split_cols; }
        const int col0 = colt + wc * 32 + 8 * fq;
#pragma unroll
        for (int ai = 0; ai < 2; ++ai)
#pragma unroll
            for (int m = 0; m < 4; ++m) { bf16_t* rowp = base + (size_t)(row0 + ai * HALF + m * 16) * ldc + col0;
#pragma unroll
                for (int bj = 0; bj < 2; ++bj) { f32x4 v0 = acc[ai][bj][m][0], v1 = acc[ai][bj][m][1];
                    if (ACT == 1) {
#pragma unroll
                        for (int e = 0; e < 4; ++e) { float a, b; asm("v_max_f32 %0, 0, %1" : "=v"(a) : "v"(v0[e])); asm("v_max_f32 %0, 0, %1" : "=v"(b) : "v"(v1[e])); v0[e] = a * a; v1[e] = b * b; } }
                    u32x4 w; w.x = cvtpk(v0[0], v0[1]); w.y = cvtpk(v0[2], v0[3]); w.z = cvtpk(v1[0], v1[1]); w.w = cvtpk(v1[2], v1[3]);
                    *(u32x4*)(rowp + bj * HALF) = w; } }
    }
};
struct EpiQ {
    static constexpr bool PERM = true;
    bf16_t* Q; const float* PCQ; const float* g_qa; const float* ROPET; LAS unsigned char* lds;
    __device__ __forceinline__ void operator()(const f32x4 (&acc)[2][2][4][2], const Unit& u, int wr, int wc, int fr_, int fq_) const {
        int fr = fr_, fq = fq_; asm volatile("" : "+v"(fr), "+v"(fq));
        const int cl = wc * 32 + 8 * fq, h = u.pn;
        LAS float* P = (LAS float*)lds;
        LAS float* PQ = (LAS float*)(lds + 8192);
        const int tid_ = ((wr * 4 + wc) * 4 + fq) * 16 + fr;
        const f32x4 pq = *(const f32x4*)(PCQ + (size_t)(u.pm * BM + (tid_ >> 1)) * 8 + (tid_ & 1) * 4);
        float gn[8]; { const f32x4 ga = *(const f32x4*)(g_qa + cl), gb = *(const f32x4*)(g_qa + cl + 4);
            gn[0] = ga[0] * QS_A; gn[1] = ga[1] * QS_A; gn[2] = ga[2] * QS_A; gn[3] = ga[3] * QS_A; gn[4] = gb[0] * QS_A; gn[5] = gb[1] * QS_A; gn[6] = gb[2] * QS_A; gn[7] = gb[3] * QS_A; }
        const int ri = 16 * (wc & 1) + 4 * fq;
        float g1[4], g2[4]; { const f32x4 a = *(const f32x4*)(g_qa + NOPE + ri), b = *(const f32x4*)(g_qa + NOPE + 32 + ri);
#pragma unroll
            for (int e = 0; e < 4; ++e) { g1[e] = a[e] * QS_A; g2[e] = b[e] * QS_A; } }
#define ROPE_POS(i) ({ const int r_ = u.pm * BM + ((i) >> 2) * HALF + wr * 64 + ((i) & 3) * 16 + fr; r_ >= MP ? PAST + ((r_ - MP) & 31) : (r_ & (SEQ - 1)); })
        f32x4 cs[2], sn[2];
        if (wc < 2) {
#pragma unroll
            for (int k = 0; k < 2; ++k) { const int pos = ROPE_POS(k); cs[k] = *(const f32x4*)(ROPET + (size_t)pos * 64 + ri); sn[k] = *(const f32x4*)(ROPET + (size_t)pos * 64 + 32 + ri); } }
        { float ss[2][4][2];
#pragma unroll
          for (int ai = 0; ai < 2; ++ai)
#pragma unroll
            for (int m = 0; m < 4; ++m)
#pragma unroll
                for (int bj = 0; bj < 2; ++bj) { const f32x4 a = acc[ai][bj][m][0], b = acc[ai][bj][m][1];
                    float s = ((a[0] * a[0] + a[1] * a[1]) + (a[2] * a[2] + a[3] * a[3])) + ((b[0] * b[0] + b[1] * b[1]) + (b[2] * b[2] + b[3] * b[3]));
                    s += __shfl_xor(s, 16); s += __shfl_xor(s, 32); ss[ai][m][bj] = s; }
          if (fq == 0) {
#pragma unroll
            for (int ai = 0; ai < 2; ++ai)
#pragma unroll
                for (int m = 0; m < 4; ++m)
#pragma unroll
                    for (int bj = 0; bj < 2; ++bj) P[(ai * HALF + wr * 64 + m * 16 + fr) * 8 + bj * 4 + wc] = ss[ai][m][bj]; } }
        PQ[tid_] = (pq[0] + pq[1]) + (pq[2] + pq[3]);
        asm volatile("s_waitcnt lgkmcnt(0)\n\ts_barrier" ::: "memory");
#pragma unroll
        for (int g = 0; g < 4; ++g) {
            f32x4 cn[2], sm[2];
            if (wc < 2 && g < 3) {
#pragma unroll
                for (int k = 0; k < 2; ++k) { const int pos = ROPE_POS(2 * g + 2 + k); cn[k] = *(const f32x4*)(ROPET + (size_t)pos * 64 + ri); sm[k] = *(const f32x4*)(ROPET + (size_t)pos * 64 + 32 + ri); } }
#pragma unroll
            for (int k = 0; k < 2; ++k) { const int i = 2 * g + k, ai = i >> 2, m = i & 3; const int rl = ai * HALF + wr * 64 + m * 16 + fr; const int r = u.pm * BM + rl;
                const f32x4 pa = *(const LAS f32x4*)(P + rl * 8), pb = *(const LAS f32x4*)(P + rl * 8 + 4);
                const f32x2 pq2 = *(const LAS f32x2*)(PQ + rl * 2); const float rq = rsqrtf((pq2[0] + pq2[1]) * (1.f / 512.f) + EPS);
                const float ssr = ((pa[0] + pa[1]) + (pa[2] + pa[3])) + ((pb[0] + pb[1]) + (pb[2] + pb[3]));
                const float rstd = rq * rsqrtf(rq * rq * ssr * (1.f / 192.f) + EPS);
                bf16_t* qp = Q + (size_t)r * 1536 + h * QKA;
                { const f32x4 v0 = acc[ai][0][m][0] * rstd, v1 = acc[ai][0][m][1] * rstd;
                  u32x4 w; w.x = cvtpk(v0[0] * gn[0], v0[1] * gn[1]); w.y = cvtpk(v0[2] * gn[2], v0[3] * gn[3]); w.z = cvtpk(v1[0] * gn[4], v1[1] * gn[5]); w.w = cvtpk(v1[2] * gn[6], v1[3] * gn[7]);
                  *(u32x4*)(qp + cl) = w; }
                if (wc < 2) {
                  const f32x4 a0 = acc[ai][1][m][0] * rstd, a1 = acc[ai][1][m][1] * rstd; float o1[4], o2[4];
#pragma unroll
                  for (int e = 0; e < 4; ++e) { const float x1 = a0[e] * g1[e], x2 = a1[e] * g2[e]; o1[e] = x1 * cs[k][e] - x2 * sn[k][e]; o2[e] = x1 * sn[k][e] + x2 * cs[k][e]; }
                  u32x4 w; w.x = cvtpk(o1[0], o1[1]); w.y = cvtpk(o1[2], o1[3]); w.z = cvtpk(o2[0], o2[1]); w.w = cvtpk(o2[2], o2[3]);
                  *(u32x4*)(qp + NOPE + cl) = w; } }
            if (wc < 2 && g < 3) { cs[0] = cn[0]; cs[1] = cn[1]; sn[0] = sm[0]; sn[1] = sm[1]; }
        }
#undef ROPE_POS
    }
};
struct EpiKV {
    static constexpr bool PERM = true;
    unsigned char* os; unsigned char* ws; const float* g_ka; LAS unsigned char* lds;
    __device__ __forceinline__ void operator()(const f32x4 (&acc)[2][2][4][2], const Unit& u, int wr, int wc, int fr_, int fq_) const {
        int fr = fr_, fq = fq_; asm volatile("" : "+v"(fr), "+v"(fq));
        const int row0 = u.pm * BM + wr * 64 + fr, colt = u.pn * BM, cl = wc * 32 + 8 * fq;
        bf16_t* KM = (bf16_t*)(os + OS_K); bf16_t* VM = (bf16_t*)(ws + WS_XN); const float* R = (const float*)(os + OS_R); const float* SSPE = (const float*)(os + OS_SSPE);
        if (colt >= 1024) {
#pragma unroll
            for (int ai = 0; ai < 2; ++ai)
#pragma unroll
                for (int m = 0; m < 4; ++m) { bf16_t* rowp = VM + (size_t)(row0 + ai * HALF + m * 16) * 1024 + (colt - 1024) + cl;
#pragma unroll
                    for (int bj = 0; bj < 2; ++bj) { const f32x4 v0 = acc[ai][bj][m][0], v1 = acc[ai][bj][m][1];
                        u32x4 w; w.x = cvtpk(v0[0], v0[1]); w.y = cvtpk(v0[2], v0[3]); w.z = cvtpk(v1[0], v1[1]); w.w = cvtpk(v1[2], v1[3]);
                        *(u32x4*)(rowp + bj * HALF) = w; } }
        } else {
            LAS float* P = (LAS float*)lds;
            const int dsl = 16 * wc + 4 * fq;
            float sp[8]; f32x4 rv[4];
            float gg[8]; { const f32x4 ga = *(const f32x4*)(g_ka + cl), gb = *(const f32x4*)(g_ka + cl + 4); gg[0] = ga[0]; gg[1] = ga[1]; gg[2] = ga[2]; gg[3] = ga[3]; gg[4] = gb[0]; gg[5] = gb[1]; gg[6] = gb[2]; gg[7] = gb[3]; }
#pragma unroll
            for (int i = 0; i < 8; ++i) sp[i] = SSPE[u.pm * BM + (i >> 2) * HALF + wr * 64 + (i & 3) * 16 + fr];
#pragma unroll
            for (int m = 0; m < 4; ++m) rv[m] = *(const f32x4*)(R + (size_t)(u.pm * BM + wr * 64 + m * 16 + fr) * 64 + dsl);
            { float ss[2][4][2];
#pragma unroll
              for (int ai = 0; ai < 2; ++ai)
#pragma unroll
                for (int m = 0; m < 4; ++m)
#pragma unroll
                    for (int bj = 0; bj < 2; ++bj) { const f32x4 a = acc[ai][bj][m][0], b = acc[ai][bj][m][1];
                        float s = ((a[0] * a[0] + a[1] * a[1]) + (a[2] * a[2] + a[3] * a[3])) + ((b[0] * b[0] + b[1] * b[1]) + (b[2] * b[2] + b[3] * b[3]));
                        s += __shfl_xor(s, 16); s += __shfl_xor(s, 32); ss[ai][m][bj] = s; }
              if (fq == 0) {
#pragma unroll
                for (int ai = 0; ai < 2; ++ai)
#pragma unroll
                    for (int m = 0; m < 4; ++m)
#pragma unroll
                        for (int bj = 0; bj < 2; ++bj) P[(ai * HALF + wr * 64 + m * 16 + fr) * 8 + bj * 4 + wc] = ss[ai][m][bj]; } }
            asm volatile("s_waitcnt lgkmcnt(0)\n\ts_barrier" ::: "memory");
            const int h0 = (colt >> 7);
#pragma unroll
            for (int ai = 0; ai < 2; ++ai) {
                f32x4 rn[4];
                if (ai == 0) {
#pragma unroll
                    for (int m = 0; m < 4; ++m) rn[m] = *(const f32x4*)(R + (size_t)(u.pm * BM + HALF + wr * 64 + m * 16 + fr) * 64 + dsl); }
#pragma unroll
                for (int m = 0; m < 4; ++m) { const int rl = ai * HALF + wr * 64 + m * 16 + fr; const int r = u.pm * BM + rl;
#pragma unroll
                    for (int bj = 0; bj < 2; ++bj) { const f32x4 pp = *(const LAS f32x4*)(P + rl * 8 + bj * 4);
                        const float rstd = rsqrtf((((pp[0] + pp[1]) + (pp[2] + pp[3])) + sp[ai * 4 + m]) * (1.f / 192.f) + EPS);
                        u32x4 w; w.x = cvtpk(acc[ai][bj][m][0][0] * rstd * gg[0], acc[ai][bj][m][0][1] * rstd * gg[1]); w.y = cvtpk(acc[ai][bj][m][0][2] * rstd * gg[2], acc[ai][bj][m][0][3] * rstd * gg[3]);
                        w.z = cvtpk(acc[ai][bj][m][1][0] * rstd * gg[4], acc[ai][bj][m][1][1] * rstd * gg[5]); w.w = cvtpk(acc[ai][bj][m][1][2] * rstd * gg[6], acc[ai][bj][m][1][3] * rstd * gg[7]);
                        *(u32x4*)(KM + (size_t)r * 1536 + (h0 + bj) * QKA + cl) = w;
                        u32x2 wr2; wr2.x = cvtpk(rv[m][0] * rstd, rv[m][1] * rstd); wr2.y = cvtpk(rv[m][2] * rstd, rv[m][3] * rstd);
                        *(u32x2*)(KM + (size_t)r * 1536 + (h0 + bj) * QKA + NOPE + dsl) = wr2; } }
                if (ai == 0) {
#pragma unroll
                    for (int m = 0; m < 4; ++m) rv[m] = rn[m]; } }
        }
    }
};
struct EpiInproj {
    static constexpr bool PERM = true;
    bf16_t* C; bf16_t* QB; bf16_t* KBP; bf16_t* KBS; bf16_t* VBP; bf16_t* VBS; float* out; const float* g_qb; const float* g_kb; const float* g_ckv; bf16_t* CKV; float* PCQ; const float* g_ka; const float* ROPET; float* RR; float* SSPE; LAS unsigned char* lds;
    __device__ __forceinline__ void operator()(const f32x4 (&acc)[2][2][4][2], const Unit& u, int wr, int wc, int fr_, int fq_) const {
        int fr = fr_, fq = fq_; asm volatile("" : "+v"(fr), "+v"(fq));
        const int row0 = u.pm * BM + wr * 64 + fr, colt = u.pn * BM, cl = wc * 32 + 8 * fq;
        const bool samp = u.pm * BM >= MP; const bool fout = samp || ((u.pm & 31) >= 30);
        if (colt == CC_CKV) {
            LAS float* P = (LAS float*)lds;
            float gg[2][8];
#pragma unroll
            for (int bj = 0; bj < 2; ++bj) { const f32x4 ga = *(const f32x4*)(g_ckv + bj * HALF + cl), gb = *(const f32x4*)(g_ckv + bj * HALF + cl + 4);
                gg[bj][0] = ga[0]; gg[bj][1] = ga[1]; gg[bj][2] = ga[2]; gg[bj][3] = ga[3]; gg[bj][4] = gb[0]; gg[bj][5] = gb[1]; gg[bj][6] = gb[2]; gg[bj][7] = gb[3]; }
            { float ss[2][4][2];
#pragma unroll
              for (int ai = 0; ai < 2; ++ai)
#pragma unroll
                for (int m = 0; m < 4; ++m)
#pragma unroll
                    for (int bj = 0; bj < 2; ++bj) { const f32x4 a = acc[ai][bj][m][0], b = acc[ai][bj][m][1];
                        float s = ((a[0] * a[0] + a[1] * a[1]) + (a[2] * a[2] + a[3] * a[3])) + ((b[0] * b[0] + b[1] * b[1]) + (b[2] * b[2] + b[3] * b[3]));
                        s += __shfl_xor(s, 16); s += __shfl_xor(s, 32); ss[ai][m][bj] = s; }
              if (fq == 0) {
#pragma unroll
                for (int ai = 0; ai < 2; ++ai)
#pragma unroll
                    for (int m = 0; m < 4; ++m)
#pragma unroll
                        for (int bj = 0; bj < 2; ++bj) P[(ai * HALF + wr * 64 + m * 16 + fr) * 8 + bj * 4 + wc] = ss[ai][m][bj]; } }
            asm volatile("s_waitcnt lgkmcnt(0)\n\ts_barrier" ::: "memory");
#pragma unroll
            for (int ai = 0; ai < 2; ++ai)
#pragma unroll
                for (int m = 0; m < 4; ++m) { const int rl = ai * HALF + wr * 64 + m * 16 + fr, r = u.pm * BM + rl; const int sidx = r - MP;
                    const f32x4 pa = *(const LAS f32x4*)(P + rl * 8), pb = *(const LAS f32x4*)(P + rl * 8 + 4);
                    const float rstd = rsqrtf((((pa[0] + pa[1]) + (pa[2] + pa[3])) + ((pb[0] + pb[1]) + (pb[2] + pb[3]))) * (1.f / 256.f) + EPS);
                    float* fo = (samp ? out + O_CKVS + (size_t)sidx * KVLORA : out + O_CKVP + (size_t)r * KVLORA) + cl;
                    bf16_t* bo = CKV + (size_t)(samp ? MP + (sidx >> 5) * KVLEN + PAST + (sidx & 31) : r) * KVLORA + cl;
#pragma unroll
                    for (int bj = 0; bj < 2; ++bj) { f32x4 v0 = acc[ai][bj][m][0] * rstd, v1 = acc[ai][bj][m][1] * rstd;
#pragma unroll
                        for (int e = 0; e < 4; ++e) { v0[e] *= gg[bj][e]; v1[e] *= gg[bj][4 + e]; }
                        *(f32x4*)(fo + bj * HALF) = v0; *(f32x4*)(fo + bj * HALF + 4) = v1;
                        u32x4 w; w.x = cvtpk(v0[0], v0[1]); w.y = cvtpk(v0[2], v0[3]); w.z = cvtpk(v1[0], v1[1]); w.w = cvtpk(v1[2], v1[3]);
                        *(u32x4*)(bo + bj * HALF) = w; } }
        } else if (colt >= CC_KPE) {
            LAS float* P = (LAS float*)lds;
            { float ss[2][4];
#pragma unroll
              for (int ai = 0; ai < 2; ++ai)
#pragma unroll
                for (int m = 0; m < 4; ++m) { const f32x4 a = acc[ai][0][m][0], b = acc[ai][0][m][1];
                    float s = ((a[0] * a[0] + a[1] * a[1]) + (a[2] * a[2] + a[3] * a[3])) + ((b[0] * b[0] + b[1] * b[1]) + (b[2] * b[2] + b[3] * b[3]));
                    s += __shfl_xor(s, 16); s += __shfl_xor(s, 32); ss[ai][m] = s; }
              if (fq == 0 && wc < 2) {
#pragma unroll
                for (int ai = 0; ai < 2; ++ai)
#pragma unroll
                    for (int m = 0; m < 4; ++m) P[(ai * HALF + wr * 64 + m * 16 + fr) * 2 + wc] = ss[ai][m]; } }
            asm volatile("s_waitcnt lgkmcnt(0)\n\ts_barrier" ::: "memory");
            if (wc < 2) { const int ri = 16 * wc + 4 * fq;
                float g1[4], g2[4]; { const f32x4 a = *(const f32x4*)(g_ka + NOPE + ri), b = *(const f32x4*)(g_ka + NOPE + 32 + ri);
#pragma unroll
                    for (int e = 0; e < 4; ++e) { g1[e] = a[e]; g2[e] = b[e]; } }
#pragma unroll
                for (int ai = 0; ai < 2; ++ai) {
                    f32x4 csr[4], snr[4];
#pragma unroll
                    for (int m = 0; m < 4; ++m) { const int r = u.pm * BM + ai * HALF + wr * 64 + m * 16 + fr; const int pos = samp ? PAST + ((r - MP) & 31) : (r & (SEQ - 1));
                        csr[m] = *(const f32x4*)(ROPET + (size_t)pos * 64 + ri); snr[m] = *(const f32x4*)(ROPET + (size_t)pos * 64 + 32 + ri); }
#pragma unroll
                    for (int m = 0; m < 4; ++m) { const int rl = ai * HALF + wr * 64 + m * 16 + fr, r = u.pm * BM + rl; const int sidx = r - MP;
                        const size_t kvrow = samp ? (size_t)MP + (sidx >> 5) * KVLEN + PAST + (sidx & 31) : (size_t)r;
                        const f32x4 a0 = acc[ai][0][m][0], a1 = acc[ai][0][m][1];
                        float* fo = samp ? out + O_KPES + (size_t)sidx * ROPE : out + O_KPEP + (size_t)r * ROPE;
                        *(f32x4*)(fo + ri) = a0; *(f32x4*)(fo + 32 + ri) = a1;
                        const f32x4 cs = csr[m], sn = snr[m]; f32x4 o1, o2;
#pragma unroll
                        for (int e = 0; e < 4; ++e) { const float x1 = a0[e] * g1[e], x2 = a1[e] * g2[e]; o1[e] = x1 * cs[e] - x2 * sn[e]; o2[e] = x1 * sn[e] + x2 * cs[e]; }
                        *(f32x4*)(RR + kvrow * 64 + cl) = o1; *(f32x4*)(RR + kvrow * 64 + cl + 4) = o2;
                        if (fq == 0 && wc == 0) SSPE[kvrow] = P[rl * 2] + P[rl * 2 + 1]; }
                    asm volatile("" ::: "memory"); } }
        } else if (colt < CC_QB) {
            const bool iskpe = false; const int c2 = colt + cl;
#pragma unroll
            for (int ai = 0; ai < 2; ++ai)
#pragma unroll
                for (int m = 0; m < 4; ++m) { bf16_t* rowp = C + (size_t)(row0 + ai * HALF + m * 16) * CP + c2;
#pragma unroll
                    for (int bj = 0; bj < 2; ++bj) { const f32x4 v0 = acc[ai][bj][m][0], v1 = acc[ai][bj][m][1];
                        u32x4 w; w.x = cvtpk(v0[0], v0[1]); w.y = cvtpk(v0[2], v0[3]); w.z = cvtpk(v1[0], v1[1]); w.w = cvtpk(v1[2], v1[3]);
                        if (!iskpe) *(u32x4*)(rowp + bj * HALF) = w; else if (bj == 0 && wc < 2) *(u32x4*)rowp = w; }
                    if (!iskpe) { float s = 0.f;
#pragma unroll
                        for (int bj = 0; bj < 2; ++bj) { const f32x4 a = acc[ai][bj][m][0], b = acc[ai][bj][m][1]; s += ((a[0] * a[0] + a[1] * a[1]) + (a[2] * a[2] + a[3] * a[3])) + ((b[0] * b[0] + b[1] * b[1]) + (b[2] * b[2] + b[3] * b[3])); }
                        s += __shfl_xor(s, 16); s += __shfl_xor(s, 32);
                        if (fq == 0) PCQ[(size_t)(row0 + ai * HALF + m * 16) * 8 + u.pn * 4 + wc] = s; } }
        } else if (colt >= CC_VB) {
            const int lc0 = colt - CC_VB + cl;
#pragma unroll
            for (int ai = 0; ai < 2; ++ai)
#pragma unroll
                for (int m = 0; m < 4; ++m) { const int r = row0 + ai * HALF + m * 16; const int sidx = r - MP;
                    bf16_t* rowp = samp ? VBS + (size_t)((sidx >> 5) * BLEN + BANDL + (sidx & 31)) * 1024 + lc0 : VBP + (size_t)r * 1024 + lc0;
                    float* fo = samp ? out + O_BVS + (size_t)sidx * 1024 + lc0 : out + O_BVP + (size_t)((r >> 13) * BANDL + (r & (SEQ - 1)) - (SEQ - BANDL)) * 1024 + lc0;
#pragma unroll
                    for (int bj = 0; bj < 2; ++bj) { const f32x4 v0 = acc[ai][bj][m][0], v1 = acc[ai][bj][m][1];
                        u32x4 w; w.x = cvtpk(v0[0], v0[1]); w.y = cvtpk(v0[2], v0[3]); w.z = cvtpk(v1[0], v1[1]); w.w = cvtpk(v1[2], v1[3]);
                        *(u32x4*)(rowp + bj * HALF) = w;
                        if (fout) { *(f32x4*)(fo + bj * HALF) = v0; *(f32x4*)(fo + bj * HALF + 4) = v1; } } }
        } else {
            const bool isq = colt < CC_KB; const int lc0 = colt - (isq ? CC_QB : CC_KB) + cl;
            LAS float* P = (LAS float*)lds;
            float gg[8]; { const float* gp = (isq ? g_qb : g_kb) + (cl & 127); const f32x4 ga = *(const f32x4*)gp, gb = *(const f32x4*)(gp + 4);
                const float sc = isq ? QS_B : 1.f; gg[0] = ga[0] * sc; gg[1] = ga[1] * sc; gg[2] = ga[2] * sc; gg[3] = ga[3] * sc; gg[4] = gb[0] * sc; gg[5] = gb[1] * sc; gg[6] = gb[2] * sc; gg[7] = gb[3] * sc; }
            float ss[2][4][2];
#pragma unroll
            for (int ai = 0; ai < 2; ++ai)
#pragma unroll
                for (int m = 0; m < 4; ++m)
#pragma unroll
                    for (int bj = 0; bj < 2; ++bj) { const f32x4 a = acc[ai][bj][m][0], b = acc[ai][bj][m][1];
                        float s = ((a[0] * a[0] + a[1] * a[1]) + (a[2] * a[2] + a[3] * a[3])) + ((b[0] * b[0] + b[1] * b[1]) + (b[2] * b[2] + b[3] * b[3]));
                        s += __shfl_xor(s, 16); s += __shfl_xor(s, 32); ss[ai][m][bj] = s; }
            if (fq == 0) {
#pragma unroll
                for (int ai = 0; ai < 2; ++ai)
#pragma unroll
                    for (int m = 0; m < 4; ++m)
#pragma unroll
                        for (int bj = 0; bj < 2; ++bj) P[(ai * HALF + wr * 64 + m * 16 + fr) * 8 + bj * 4 + wc] = ss[ai][m][bj]; }
            asm volatile("s_waitcnt lgkmcnt(0)\n\ts_barrier" ::: "memory");
#pragma unroll
            for (int ai = 0; ai < 2; ++ai)
#pragma unroll
                for (int m = 0; m < 4; ++m) { const int rl = ai * HALF + wr * 64 + m * 16 + fr, r = u.pm * BM + rl; const int sidx = r - MP;
                    bf16_t* rowp = isq ? QB + (size_t)r * 1024 + lc0 : (samp ? KBS + (size_t)((sidx >> 5) * BLEN + BANDL + (sidx & 31)) * 1024 + lc0 : KBP + (size_t)r * 1024 + lc0);
                    float* fo = samp ? out + O_BKS + (size_t)sidx * 1024 + lc0 : out + O_BKP + (size_t)((r >> 13) * BANDL + (r & (SEQ - 1)) - (SEQ - BANDL)) * 1024 + lc0;
#pragma unroll
                    for (int bj = 0; bj < 2; ++bj) { const f32x4 pp = *(const LAS f32x4*)(P + rl * 8 + bj * 4);
                        const float rstd = rsqrtf(((pp[0] + pp[1]) + (pp[2] + pp[3])) * (1.f / 128.f) + EPS);
                        f32x4 v0 = acc[ai][bj][m][0] * rstd, v1 = acc[ai][bj][m][1] * rstd;
#pragma unroll
                        for (int e = 0; e < 4; ++e) { v0[e] *= gg[e]; v1[e] *= gg[4 + e]; }
                        u32x4 w; w.x = cvtpk(v0[0], v0[1]); w.y = cvtpk(v0[2], v0[3]); w.z = cvtpk(v1[0], v1[1]); w.w = cvtpk(v1[2], v1[3]);
                        *(u32x4*)(rowp + bj * HALF) = w;
                        if (!isq && fout) { *(f32x4*)(fo + bj * HALF) = v0; *(f32x4*)(fo + bj * HALF + 4) = v1; } } }
        }
    }
};
struct EpiResF32 {
    static constexpr bool PERM = false;
    const float* base; const float* base2; float* out;
    __device__ __forceinline__ void operator()(const f32x4 (&acc)[2][2][4][2], const Unit& u, int wr, int wc, int fr, int fq) const {
        const int rowt = u.pm * BM; const float* bp = base + (size_t)rowt * DM;
        if (base2 && rowt >= MP) bp = base2 + (size_t)(rowt - MP) * DM;
        const int col0 = u.pn * BM + wc * 32 + 4 * fq;
#pragma unroll
        for (int ai = 0; ai < 2; ++ai)
#pragma unroll
            for (int m = 0; m < 4; ++m) { const int r = ai * HALF + wr * 64 + m * 16 + fr; const size_t off = (size_t)r * DM + col0;
#pragma unroll
                for (int bj = 0; bj < 2; ++bj)
#pragma unroll
                    for (int n = 0; n < 2; ++n) { const f32x4 bs = *(const f32x4*)(bp + off + bj * HALF + n * 16); *(f32x4*)(out + (size_t)rowt * DM + off + bj * HALF + n * 16) = bs + acc[ai][bj][m][n]; }
                if (m & 1) asm volatile("" ::: "memory"); }
    }
};

struct EpiResBf16 {
    static constexpr bool PERM = true;
    const float* base0; const float* base2; bf16_t* out; float* PH;
    __device__ __forceinline__ void operator()(const f32x4 (&acc)[2][2][4][2], const Unit& u, int wr, int wc, int fr_, int fq_) const {
        int fr = fr_, fq = fq_; asm volatile("" : "+v"(fr), "+v"(fq));
        const int row0 = u.pm * BM + wr * 64 + fr, col0 = u.pn * BM + wc * 32 + 8 * fq;
        const float* base = (base2 && u.pm * BM >= MP) ? base2 - (size_t)MP * DM : base0;
#pragma unroll
        for (int ai = 0; ai < 2; ++ai) {
            f32x4 xr[4][2][2];
#pragma unroll
            for (int m = 0; m < 4; ++m) { const size_t off = (size_t)(row0 + ai * HALF + m * 16) * DM + col0;
#pragma unroll
                for (int bj = 0; bj < 2; ++bj) { xr[m][bj][0] = *(const f32x4*)(base + off + bj * HALF); xr[m][bj][1] = *(const f32x4*)(base + off + bj * HALF + 4); } }
#pragma unroll
            for (int m = 0; m < 4; ++m) { const size_t off = (size_t)(row0 + ai * HALF + m * 16) * DM + col0; float s = 0.f;
#pragma unroll
                for (int bj = 0; bj < 2; ++bj) {
                    const f32x4 v0 = acc[ai][bj][m][0] + xr[m][bj][0], v1 = acc[ai][bj][m][1] + xr[m][bj][1];
                    s += ((v0[0] * v0[0] + v0[1] * v0[1]) + (v0[2] * v0[2] + v0[3] * v0[3])) + ((v1[0] * v1[0] + v1[1] * v1[1]) + (v1[2] * v1[2] + v1[3] * v1[3]));
                    u32x4 w; w.x = cvtpk(v0[0], v0[1]); w.y = cvtpk(v0[2], v0[3]); w.z = cvtpk(v1[0], v1[1]); w.w = cvtpk(v1[2], v1[3]);
                    *(u32x4*)(out + off + bj * HALF) = w; }
                s += __shfl_xor(s, 16); s += __shfl_xor(s, 32);
                if (fq == 0) PH[(size_t)(row0 + ai * HALF + m * 16) * 32 + u.pn * 4 + wc] = s; }
            asm volatile("" ::: "memory"); }
    }
};
struct EpiAddBf16 {
    static constexpr bool PERM = false;
    const bf16_t* hb; float* out; const float* RS2;
    __device__ __forceinline__ void operator()(const f32x4 (&acc)[2][2][4][2], const Unit& u, int wr, int wc, int fr_, int fq_) const {
        int fr = fr_, fq = fq_; asm volatile("" : "+v"(fr), "+v"(fq));
        const int rowt = u.pm * BM, col0 = u.pn * BM + wc * 32 + 4 * fq;
#pragma unroll
        for (int ai = 0; ai < 2; ++ai) {
            u32x2 hw[4][2][2]; float rs2[4];
#pragma unroll
            for (int m = 0; m < 4; ++m) { const int r = rowt + ai * HALF + wr * 64 + m * 16 + fr; const size_t off = (size_t)r * DM + col0; rs2[m] = RS2[r];
#pragma unroll
                for (int bj = 0; bj < 2; ++bj)
#pragma unroll
                    for (int n = 0; n < 2; ++n) hw[m][bj][n] = *(const u32x2*)(hb + off + bj * HALF + n * 16); }
#pragma unroll
            for (int m = 0; m < 4; ++m) { const int r = rowt + ai * HALF + wr * 64 + m * 16 + fr; const size_t off = (size_t)r * DM + col0;
#pragma unroll
                for (int bj = 0; bj < 2; ++bj)
#pragma unroll
                    for (int n = 0; n < 2; ++n) { const u32x2 w = hw[m][bj][n];
                        const f32x4 h = {bflo(w.x), bfhi(w.x), bflo(w.y), bfhi(w.y)}; __builtin_nontemporal_store(h + acc[ai][bj][m][n] * rs2[m], (f32x4*)(out + off + bj * HALF + n * 16)); } }
            asm volatile("" ::: "memory"); }
    }
};
struct EpiSlab {
    static constexpr bool PERM = false;
    float* S; int nN;
    __device__ __forceinline__ void operator()(const f32x4 (&acc)[2][2][4][2], const Unit& u, int wr, int wc, int fr, int fq) const {
        float* tile = S + (nN ? (size_t)(u.pm * nN + u.pn) * 65536 : (size_t)0);
        const __amdgpu_buffer_rsrc_t rsrc = __builtin_amdgcn_make_buffer_rsrc((void*)tile, 0, 65536 * 4, 0x00020000);
        const unsigned c0 = (unsigned)(wc * 32 + 4 * fq) * 4u;
#pragma unroll
        for (int ai = 0; ai < 2; ++ai)
#pragma unroll
            for (int m = 0; m < 4; ++m) { const unsigned r = (unsigned)(ai * HALF + wr * 64 + m * 16 + fr);
#pragma unroll
                for (int bj = 0; bj < 2; ++bj)
#pragma unroll
                    for (int n = 0; n < 2; ++n) __builtin_amdgcn_raw_buffer_store_b128(__builtin_bit_cast(u32x4, acc[ai][bj][m][n]), rsrc, r * 1024u + c0 + (unsigned)(bj * HALF + n * 16) * 4u, 0,   16); }
    }
};
struct OneUnit { int pm, pn; bool on;
    __device__ bool next(int i, Unit& u) const { if (i > 0 || !on) return false; u.pm = pm; u.pn = pn; return true; } };

template <class Epi, class Sched>
__device__ __forceinline__ void gemm_phase(LAS unsigned char* lds, const Gemm g, const Sched& S, const Epi& E, const int wid) {
    const int lane = lane_now(), tid = wid * 64 + lane, wr = wid >> 2, wc = wid & 3, fr = lane & 15, fq = lane >> 4;
    const int K = g.K, nt = K / BK;
    unsigned voffA[2], voffB[2];
#pragma unroll
    for (int i = 0; i < 2; ++i) { int R, C; stage_rc(tid * 16 + i * 8192, R, C); const int Rb = Epi::PERM ? ((R & ~31) + perm32(R & 31)) : R;
        voffA[i] = (unsigned)(R * g.lda + C) * 2u; voffB[i] = (unsigned)(Rb * g.ldb + C) * 2u; }
    const size_t kstep = (size_t)(BK * 2);
    const size_t hstepA = (size_t)HALF * g.lda * 2, hstepB = (size_t)HALF * g.ldb * 2;
    const size_t tstepA = 2 * hstepA, tstepB = 2 * hstepB;
    const unsigned ldsw = (unsigned)wid * 1024u;
    const int aoff = lds_byte(wr * 64 + fr, fq * 8), boff = lds_byte(wc * 32 + fr, fq * 8);
#define PG8_SA(b, h) (((b) * 2 + (h)) * HTB)
#define PG8_SB(b, h) ((4 + (b) * 2 + (h)) * HTB)
#define PG8_STAGE(bufoff, gbase, voff) do { _Pragma("unroll") for (int _i = 0; _i < 2; ++_i) \
        __builtin_amdgcn_global_load_lds((const unsigned*)((const char*)(gbase) + (voff)[_i]), (LAS unsigned*)(lds + (bufoff) + ldsw + _i * 8192), 16, 0, 0); } while (0)
#define PG8_LDA(dst, b, h) do { _Pragma("unroll") for (int m = 0; m < 4; ++m) _Pragma("unroll") for (int k = 0; k < 2; ++k) dst[m][k] = *(const LAS bf16x8*)(lds + PG8_SA(b, h) + aoff + m * 2048 + k * 1024); } while (0)
#define PG8_LDB(dst, b, h) do { _Pragma("unroll") for (int n = 0; n < 2; ++n) _Pragma("unroll") for (int k = 0; k < 2; ++k) dst[n][k] = *(const LAS bf16x8*)(lds + PG8_SB(b, h) + boff + n * 2048 + k * 1024); } while (0)
#define PG8_MMA(ai, bj, At, Bt) do { __builtin_amdgcn_s_setprio(1); _Pragma("unroll") for (int m = 0; m < 4; ++m) _Pragma("unroll") for (int n = 0; n < 2; ++n) _Pragma("unroll") for (int k = 0; k < 2; ++k) \
        acc[ai][bj][m][n] = __builtin_amdgcn_mfma_f32_16x16x32_bf16(Bt[n][k], At[m][k], acc[ai][bj][m][n], 0, 0, 0); __builtin_amdgcn_s_setprio(0); } while (0)
#define PG8_WAIT_V(n) asm volatile("s_waitcnt vmcnt(" #n ")" ::: "memory")
#define PG8_WAIT_L(n) asm volatile("s_waitcnt lgkmcnt(" #n ")" ::: "memory")
#define PG8_BAR __builtin_amdgcn_s_barrier()
#define PG8_SCHED __builtin_amdgcn_sched_barrier(0)
    Unit cur, nxt; int ui = 0;
    if (!S.next(0, cur)) return;
    f32x4 acc[2][2][4][2];
#pragma unroll
    for (int a = 0; a < 2; ++a)
#pragma unroll
        for (int b = 0; b < 2; ++b)
#pragma unroll
            for (int m = 0; m < 4; ++m)
#pragma unroll
                for (int n = 0; n < 2; ++n) acc[a][b][m][n] = (f32x4){0.f, 0.f, 0.f, 0.f};
    bf16x8 At[4][2], B0[2][2], B1[2][2];
    const char* cA = (const char*)g.A + (size_t)cur.pm * tstepA; const char* cB = (const char*)g.Bt + (size_t)cur.pn * tstepB;
    PG8_STAGE(PG8_SB(0, 0), cB, voffB); PG8_STAGE(PG8_SB(0, 1), cB + hstepB, voffB); PG8_STAGE(PG8_SA(0, 0), cA, voffA); PG8_STAGE(PG8_SA(0, 1), cA + hstepA, voffA);
    if (wr == 1) PG8_BAR;
    PG8_WAIT_V(2); PG8_BAR;
    PG8_STAGE(PG8_SB(1, 0), cB + kstep, voffB); PG8_STAGE(PG8_SA(1, 0), cA + kstep, voffA); PG8_STAGE(PG8_SB(1, 1), cB + hstepB + kstep, voffB);
    PG8_WAIT_V(6); PG8_BAR;
    for (;;) {
        const bool has_next = S.next(ui + 1, nxt);
        const char* nA = has_next ? (const char*)g.A + (size_t)nxt.pm * tstepA : cA; const char* nB = has_next ? (const char*)g.Bt + (size_t)nxt.pn * tstepB : cB;
#pragma unroll 1
        for (int t = 0; t < nt; t += 2) {
            const bool last = (t == nt - 2);
            const char* a1 = cA + (size_t)(t + 1) * kstep;
            const char* a2 = last ? nA : cA + (size_t)(t + 2) * kstep; const char* b2 = last ? nB : cB + (size_t)(t + 2) * kstep;
            const char* a3 = a2 + kstep; const char* b3 = b2 + kstep;
            PG8_LDB(B0, 0, 0); PG8_LDB(B1, 0, 1); PG8_SCHED; PG8_LDA(At, 0, 0); PG8_STAGE(PG8_SA(1, 1), a1 + hstepA, voffA);
            PG8_WAIT_V(8); PG8_WAIT_L(0); PG8_BAR; PG8_MMA(0, 0, At, B0); PG8_MMA(0, 1, At, B1); PG8_BAR; PG8_SCHED;
            PG8_LDA(At, 0, 1); PG8_STAGE(PG8_SB(0, 0), b2, voffB); PG8_STAGE(PG8_SB(0, 1), b2 + hstepB, voffB); PG8_STAGE(PG8_SA(0, 0), a2, voffA);
            PG8_WAIT_V(8); PG8_WAIT_L(0); PG8_BAR; PG8_MMA(1, 0, At, B0); PG8_MMA(1, 1, At, B1); PG8_BAR; PG8_SCHED;
            PG8_LDB(B0, 1, 0); PG8_LDB(B1, 1, 1); PG8_SCHED; PG8_LDA(At, 1, 0); PG8_STAGE(PG8_SA(0, 1), a2 + hstepA, voffA);
            PG8_WAIT_V(8); PG8_WAIT_L(0); PG8_BAR; PG8_MMA(0, 0, At, B0); PG8_MMA(0, 1, At, B1); PG8_BAR; PG8_SCHED;
            PG8_LDA(At, 1, 1); PG8_STAGE(PG8_SB(1, 0), b3, voffB); PG8_STAGE(PG8_SB(1, 1), b3 + hstepB, voffB); PG8_STAGE(PG8_SA(1, 0), a3, voffA);
            PG8_WAIT_V(8); PG8_WAIT_L(0); PG8_BAR; PG8_MMA(1, 0, At, B0); PG8_MMA(1, 1, At, B1); PG8_BAR; PG8_SCHED;
        }
        if (wr == 0) PG8_BAR;
        E(acc, cur, wr, wc, fr, fq);
        if (!has_next) break;
#pragma unroll
        for (int a = 0; a < 2; ++a)
#pragma unroll
            for (int b = 0; b < 2; ++b)
#pragma unroll
                for (int m = 0; m < 4; ++m)
#pragma unroll
                    for (int n = 0; n < 2; ++n) acc[a][b][m][n] = (f32x4){0.f, 0.f, 0.f, 0.f};
        cur = nxt; cA = nA; cB = nB; ++ui;
        if (wr == 1) PG8_BAR;
    }
    PG8_WAIT_V(0);
    PG8_BAR;
#undef PG8_SA
#undef PG8_SB
#undef PG8_STAGE
#undef PG8_LDA
#undef PG8_LDB
#undef PG8_MMA
#undef PG8_WAIT_V
#undef PG8_WAIT_L
#undef PG8_BAR
#undef PG8_SCHED
}
}

namespace att {
constexpr int KSLOT = 24576, VSLOT = 16384, NSLOT = 3;
constexpr int L_K = 0, L_V = NSLOT * KSLOT, L_WS = L_V + NSLOT * VSLOT, L_BIAS = L_WS + 8 * 512, L_END = L_BIAS + 2048;
constexpr float THRL = 6.0f;
#define SBAR() __builtin_amdgcn_sched_barrier(0)
__device__ __forceinline__ int crow(int r, int hi) { return (r & 3) + 8 * (r >> 2) + 4 * hi; }
__device__ __forceinline__ void glds16(const void* sbase, unsigned voff, unsigned lds_dst) { unsigned keep;
    asm volatile("s_mov_b32 %0, m0\n\ts_mov_b32 m0, %3\n\ts_nop 4\n\tglobal_load_lds_dwordx4 %1, %2\n\ts_mov_b32 m0, %0" : "=&s"(keep) : "v"(voff), "s"(sbase), "s"(lds_dst) : "memory"); }
template <int OFF> __device__ __forceinline__ s16x4 tr_read(int vb) { s16x4 r; asm volatile("ds_read_b64_tr_b16 %0, %1 offset:%2" : "=&v"(r) : "v"(vb), "i"(OFF) : "memory"); return r; }
__device__ __forceinline__ int v_rd_base(int lane) { return ((lane & 3) << 3) | (((lane >> 2) & 3) << 6) | (((lane >> 4) & 1) << 5) | (((lane >> 5) & 1) << 8); }
constexpr int v_rd_off(int d0, int ks, int half) { return d0 * 512 + ks * 4096 + half * 2048; }
template <int D0> __device__ __forceinline__ void pv_one(f32x16& od, int vb, bf16x8 pa0, bf16x8 pa1, bf16x8 pa2, bf16x8 pa3) {
    const s16x4 l0 = tr_read<v_rd_off(D0, 0, 0)>(vb), h0 = tr_read<v_rd_off(D0, 0, 1)>(vb), l1 = tr_read<v_rd_off(D0, 1, 0)>(vb), h1 = tr_read<v_rd_off(D0, 1, 1)>(vb);
    const s16x4 l2 = tr_read<v_rd_off(D0, 2, 0)>(vb), h2 = tr_read<v_rd_off(D0, 2, 1)>(vb), l3 = tr_read<v_rd_off(D0, 3, 0)>(vb), h3 = tr_read<v_rd_off(D0, 3, 1)>(vb);
    asm volatile("s_waitcnt lgkmcnt(0)" ::: "memory"); SBAR();
#define PK(L, H) (bf16x8){L[0], L[1], L[2], L[3], H[0], H[1], H[2], H[3]}
    od = __builtin_amdgcn_mfma_f32_32x32x16_bf16(pa0, PK(l0, h0), od, 0, 0, 0);
    od = __builtin_amdgcn_mfma_f32_32x32x16_bf16(pa1, PK(l1, h1), od, 0, 0, 0);
    od = __builtin_amdgcn_mfma_f32_32x32x16_bf16(pa2, PK(l2, h2), od, 0, 0, 0);
    od = __builtin_amdgcn_mfma_f32_32x32x16_bf16(pa3, PK(l3, h3), od, 0, 0, 0);
#undef PK
}

struct UnitDesc {
    const bf16_t* Q; int ldq;
    const bf16_t* K; int ldk;
    const bf16_t* V; int ldv;
    bf16_t* O; int ldo;
    int t0, t1;
    int wlo, whi;
    int half_last;
    int rb0, rbstep, qi;
};

template <int DQK, bool BIAS>
__device__ __forceinline__ void attn_unit(const UnitDesc& u, LAS unsigned char* lds, const float* biasg  , const int wid) {
    constexpr int ND0 = DQK / 16;
    constexpr bool HASR = DQK > 128;
    constexpr int NDMA = HASR ? 5 : 4;
    const int lane = lane_now(), tid = wid * 64 + lane, r32 = lane & 31, hi = lane >> 5;
    const unsigned lds0 = (unsigned)(uintptr_t)lds;
    LAS float* wsf = (LAS float*)(lds + L_WS) + wid * 128;
    LAS float* bl = (LAS float*)(lds + L_BIAS);
    const bool active = u.wlo <= u.whi;
    unsigned koff[2], voff[2], roff = 0;
#pragma unroll
    for (int j = 0; j < 2; ++j) { const int i = 2 * wid + j;
        { const int row = 4 * i + (lane >> 4), c = (lane & 15) ^ (row & 7); koff[j] = (unsigned)(row * u.ldk + c * 8) * 2u; }
        { const int kk = (i >> 1) * 8 + ((lane & 31) >> 2), k = (kk & ~0xC) | ((kk & 4) << 1) | ((kk & 8) >> 1), col = (((2 * i + (lane >> 5)) & 3) << 5) + ((lane & 3) << 3); voff[j] = (unsigned)(k * u.ldv + col) * 2u; } }
    if (HASR) { const int row = 8 * wid + (lane >> 3), c = (lane & 7) ^ ((row >> 1) & 7); roff = (unsigned)(row * u.ldk + 128 + c * 8) * 2u; }
    const unsigned kdst = lds0 + L_K + (unsigned)wid * 2048u, rdst = lds0 + L_K + 16384u + (unsigned)wid * 1024u, vdst = lds0 + L_V + (unsigned)wid * 2048u;
#define UNI64(p) ((const void*)(((unsigned long long)(unsigned)__builtin_amdgcn_readfirstlane((int)((unsigned long long)(p) >> 32)) << 32) | (unsigned long long)(unsigned)__builtin_amdgcn_readfirstlane((int)(unsigned)(unsigned long long)(p))))
#define DMA_TILE(t, slot) do { const void* kb_ = UNI64(u.K + (size_t)(t) * 64 * u.ldk); const void* vb_ = UNI64(u.V + (size_t)(t) * 64 * u.ldv); \
        glds16(kb_, koff[0], (unsigned)__builtin_amdgcn_readfirstlane(kdst + (slot) * KSLOT)); glds16(kb_, koff[1], (unsigned)__builtin_amdgcn_readfirstlane(kdst + (slot) * KSLOT + 1024)); \
        if (HASR) glds16(kb_, roff, (unsigned)__builtin_amdgcn_readfirstlane(rdst + (slot) * KSLOT)); \
        glds16(vb_, voff[0], (unsigned)__builtin_amdgcn_readfirstlane(vdst + (slot) * VSLOT)); glds16(vb_, voff[1], (unsigned)__builtin_amdgcn_readfirstlane(vdst + (slot) * VSLOT + 1024)); } while (0)
    const int n = u.t1 - u.t0;
    bf16x8 qr[ND0];
    { const bf16_t* Qw = u.Q + (size_t)(wid * 32 + r32) * u.ldq + hi * 8;
#pragma unroll
      for (int d0 = 0; d0 < ND0; ++d0) qr[d0] = active ? *(const bf16x8*)(Qw + d0 * 16) : (bf16x8){0, 0, 0, 0, 0, 0, 0, 0}; }
    float bias_v = 0.f; if (BIAS && tid < NREL) bias_v = biasg[tid];
    DMA_TILE(u.t0, 0);
    if (n > 1) DMA_TILE(u.t0 + 1, 1);
    if (BIAS && tid < NREL) bl[tid] = bias_v * LOG2E;
    float m_reg = -1e30f, l_reg = 0.f; f32x16 o[4];
#pragma unroll
    for (int d = 0; d < 4; ++d) o[d] = f32x16{};
    const int vb0 = (int)(lds0 + L_V) + v_rd_base(lane);
    int slot = 0;
    __builtin_amdgcn_s_waitcnt(0x0F70);
    for (int j = 0; j < n; ++j) {
        const int t = u.t0 + j;
        if (j + 1 < n) { if (HASR) asm volatile("s_waitcnt vmcnt(5) lgkmcnt(0)\n\ts_barrier" ::: "memory"); else asm volatile("s_waitcnt vmcnt(4) lgkmcnt(0)\n\ts_barrier" ::: "memory"); }
        else asm volatile("s_waitcnt vmcnt(0) lgkmcnt(0)\n\ts_barrier" ::: "memory");
        if (j + 2 < n) { const int s2 = slot == 0 ? 2 : slot - 1; DMA_TILE(t + 2, s2); }
        if (t >= u.wlo && t <= u.whi) {
            const LAS unsigned char* Kb = lds + L_K + slot * KSLOT;
            const bool halfm = u.half_last && (t == u.t1 - 1);
            f32x16 p0, p1;
#pragma unroll
            for (int r = 0; r < 16; ++r) { p0[r] = -16.f; p1[r] = -16.f; }
#pragma unroll
            for (int d0 = 0; d0 < 8; ++d0) { const int ch = d0 * 2 + hi;
                const bf16x8 b0 = *(const LAS bf16x8*)(Kb + r32 * 256 + ((ch ^ (r32 & 7)) << 4));
                const bf16x8 b1 = *(const LAS bf16x8*)(Kb + (32 + r32) * 256 + ((ch ^ (r32 & 7)) << 4));
                p0 = __builtin_amdgcn_mfma_f32_32x32x16_bf16(b0, qr[d0], p0, 0, 0, 0);
                p1 = __builtin_amdgcn_mfma_f32_32x32x16_bf16(b1, qr[d0], p1, 0, 0, 0); }
            if (HASR) {
#pragma unroll
                for (int d0 = 8; d0 < ND0; ++d0) { const int ch = (d0 - 8) * 2 + hi;
                    const bf16x8 b0 = *(const LAS bf16x8*)(Kb + 16384 + r32 * 128 + ((ch ^ ((r32 >> 1) & 7)) << 4));
                    const bf16x8 b1 = *(const LAS bf16x8*)(Kb + 16384 + (32 + r32) * 128 + ((ch ^ (((32 + r32) >> 1) & 7)) << 4));
                    p0 = __builtin_amdgcn_mfma_f32_32x32x16_bf16(b0, qr[d0], p0, 0, 0, 0);
                    p1 = __builtin_amdgcn_mfma_f32_32x32x16_bf16(b1, qr[d0], p1, 0, 0, 0); } }
            __builtin_amdgcn_sched_group_barrier(0x100, 4, 0);
#pragma unroll
            for (int i_ = 0; i_ < 2 * ND0 - 4; ++i_) { __builtin_amdgcn_sched_group_barrier(0x8, 1, 0); __builtin_amdgcn_sched_group_barrier(0x100, 1, 0); }
            __builtin_amdgcn_sched_group_barrier(0x8, 4, 0);
            if (BIAS) {
                const int rbu = u.rb0 + u.rbstep * t, rb = rbu + u.qi;
                if (rbu - 63 >= MAXREL) { const float bc = bl[2 * MAXREL];
#pragma unroll
                    for (int r = 0; r < 16; ++r) { p0[r] += bc; p1[r] += bc; } }
                else {
#pragma unroll
                    for (int r = 0; r < 16; ++r) { const int k0 = crow(r, hi); int i0 = rb - k0, i1 = rb - k0 - 32;
                        i0 = min(max(i0, -MAXREL), MAXREL) + MAXREL; i1 = min(max(i1, -MAXREL), MAXREL) + MAXREL;
                        p0[r] += bl[i0]; p1[r] += bl[i1]; } }
            }
            if (halfm) {
#pragma unroll
                for (int r = 0; r < 16; ++r) p1[r] = -INFINITY; }
            float ps = 0.f;
#pragma unroll
            for (int r = 0; r < 16; ++r) { p0[r] = __builtin_amdgcn_exp2f(p0[r]); ps += p0[r]; }
#pragma unroll
            for (int r = 0; r < 16; ++r) { p1[r] = __builtin_amdgcn_exp2f(p1[r]); ps += p1[r]; }
            l_reg += ps;
            bf16x8 pa0, pa1, pa2, pa3;
#define PK4(P, BASE, OUT) do { unsigned a0 = cvtpk(P[BASE + 0], P[BASE + 1]), a1 = cvtpk(P[BASE + 2], P[BASE + 3]); \
    unsigned b0_ = cvtpk(P[BASE + 4], P[BASE + 5]), b1_ = cvtpk(P[BASE + 6], P[BASE + 7]); \
    auto r0 = __builtin_amdgcn_permlane32_swap(a0, b0_, false, false); auto r1 = __builtin_amdgcn_permlane32_swap(a1, b1_, false, false); \
    u32x4 w = {r0[0], r1[0], r0[1], r1[1]}; OUT = __builtin_bit_cast(bf16x8, w); } while (0)
            PK4(p0, 0, pa0); PK4(p0, 8, pa1); PK4(p1, 0, pa2); PK4(p1, 8, pa3);
#undef PK4
            const int vb = vb0 + slot * VSLOT;
            pv_one<0>(o[0], vb, pa0, pa1, pa2, pa3); pv_one<1>(o[1], vb, pa0, pa1, pa2, pa3); pv_one<2>(o[2], vb, pa0, pa1, pa2, pa3); pv_one<3>(o[3], vb, pa0, pa1, pa2, pa3);
        }
        slot = slot == 2 ? 0 : slot + 1;
    }
    asm volatile("s_waitcnt lgkmcnt(0)\n\ts_barrier" ::: "memory");
    if (active) {
        { auto rr = __builtin_amdgcn_permlane32_swap(__float_as_uint(l_reg), __float_as_uint(l_reg), false, false); l_reg = __uint_as_float(rr[0]) + __uint_as_float(rr[1]); }
        if (hi == 0) wsf[32 + r32] = l_reg; LDS_WAIT();
        LAS bf16_t* st = (LAS bf16_t*)(lds + wid * 8192);
#pragma unroll
        for (int r = 0; r < 16; ++r) { const int orow = crow(r, hi); const float rl = __builtin_amdgcn_rcpf(wsf[32 + orow]);
#pragma unroll
            for (int d0 = 0; d0 < 4; ++d0) { const unsigned w = cvtpk(o[d0][r] * rl, 0.f); st[orow * 128 + d0 * 32 + r32] = (bf16_t)(w & 0xffffu); } }
        LDS_WAIT();
        bf16_t* Ow = u.O + (size_t)(wid * 32) * u.ldo;
#pragma unroll
        for (int i = 0; i < 8; ++i) { const int row = i * 4 + (lane >> 4), ch = lane & 15; const u32x4 v = *(const LAS u32x4*)(st + row * 128 + ch * 8); *(u32x4*)(Ow + (size_t)row * u.ldo + ch * 8) = v; }
    }
    asm volatile("s_waitcnt lgkmcnt(0)\n\ts_barrier" ::: "memory");
#undef DMA_TILE
}

template <int DQK, bool BIAS>
__device__ __forceinline__ void attn_unit_ks(const UnitDesc& u, LAS unsigned char* lds, const float* biasg, const int wid) {
    constexpr int ND0 = DQK / 16;
    constexpr bool HASR = DQK > 128;
    constexpr int NDMA = HASR ? 5 : 4;
    const int lane = lane_now(), tid = wid * 64 + lane, r32 = lane & 31, hi = lane >> 5;
    const unsigned lds0 = (unsigned)(uintptr_t)lds;
    LAS float* wsf = (LAS float*)(lds + L_WS) + wid * 128;
    LAS float* bl = (LAS float*)(lds + L_BIAS);
    const bool active = wid < 2;
    unsigned koff[2], voff[2], roff = 0;
#pragma unroll
    for (int j = 0; j < 2; ++j) { const int i = 2 * wid + j;
        { const int row = 4 * i + (lane >> 4), c = (lane & 15) ^ (row & 7); koff[j] = (unsigned)(row * u.ldk + c * 8) * 2u; }
        { const int kk = (i >> 1) * 8 + ((lane & 31) >> 2), k = (kk & ~0xC) | ((kk & 4) << 1) | ((kk & 8) >> 1), col = (((2 * i + (lane >> 5)) & 3) << 5) + ((lane & 3) << 3); voff[j] = (unsigned)(k * u.ldv + col) * 2u; } }
    if (HASR) { const int row = 8 * wid + (lane >> 3), c = (lane & 7) ^ ((row >> 1) & 7); roff = (unsigned)(row * u.ldk + 128 + c * 8) * 2u; }
    const unsigned kdst = lds0 + L_K + (unsigned)wid * 2048u, rdst = lds0 + L_K + 16384u + (unsigned)wid * 1024u, vdst = lds0 + L_V + (unsigned)wid * 2048u;
#define DMA_TILE(t, slot) do { const void* kb_ = UNI64(u.K + (size_t)(t) * 64 * u.ldk); const void* vb_ = UNI64(u.V + (size_t)(t) * 64 * u.ldv); \
        glds16(kb_, koff[0], (unsigned)__builtin_amdgcn_readfirstlane(kdst + (slot) * KSLOT)); glds16(kb_, koff[1], (unsigned)__builtin_amdgcn_readfirstlane(kdst + (slot) * KSLOT + 1024)); \
        if (HASR) glds16(kb_, roff, (unsigned)__builtin_amdgcn_readfirstlane(rdst + (slot) * KSLOT)); \
        glds16(vb_, voff[0], (unsigned)__builtin_amdgcn_readfirstlane(vdst + (slot) * VSLOT)); glds16(vb_, voff[1], (unsigned)__builtin_amdgcn_readfirstlane(vdst + (slot) * VSLOT + 1024)); } while (0)
    const int n = u.t1 - u.t0;
    bf16x8 qr[ND0];
    { const bf16_t* Qw = u.Q + (size_t)r32 * u.ldq + hi * 8;
#pragma unroll
      for (int d0 = 0; d0 < ND0; ++d0) qr[d0] = active ? *(const bf16x8*)(Qw + d0 * 16) : (bf16x8){0, 0, 0, 0, 0, 0, 0, 0}; }
    float bias_v = 0.f; if (BIAS && tid < NREL) bias_v = biasg[tid];
    DMA_TILE(u.t0, 0);
    if (n > 1) DMA_TILE(u.t0 + 1, 1);
    if (BIAS && tid < NREL) bl[tid] = bias_v * LOG2E;
    float l_reg = 0.f; f32x16 o[4];
#pragma unroll
    for (int d = 0; d < 4; ++d) o[d] = f32x16{};
    const int krow = wid * 32 + r32;
    const int vb0 = (int)(lds0 + L_V) + v_rd_base(lane) + wid * 8192;
    const int wlast = wid == 0 ? u.t1 - 1 : u.t1 - 2;
    int slot = 0;
    __builtin_amdgcn_s_waitcnt(0x0F70);
    for (int j = 0; j < n; ++j) {
        const int t = u.t0 + j;
        if (j + 1 < n) { if (HASR) asm volatile("s_waitcnt vmcnt(5) lgkmcnt(0)\n\ts_barrier" ::: "memory"); else asm volatile("s_waitcnt vmcnt(4) lgkmcnt(0)\n\ts_barrier" ::: "memory"); }
        else asm volatile("s_waitcnt vmcnt(0) lgkmcnt(0)\n\ts_barrier" ::: "memory");
        if (j + 2 < n) { const int s2 = slot == 0 ? 2 : slot - 1; DMA_TILE(t + 2, s2); }
        if (active && t <= wlast) {
            const LAS unsigned char* Kb = lds + L_K + slot * KSLOT;
            f32x16 pk;
#pragma unroll
            for (int r = 0; r < 16; ++r) pk[r] = -16.f;
#pragma unroll
            for (int d0 = 0; d0 < 8; ++d0) { const int ch = d0 * 2 + hi;
                const bf16x8 b = *(const LAS bf16x8*)(Kb + krow * 256 + ((ch ^ (r32 & 7)) << 4));
                pk = __builtin_amdgcn_mfma_f32_32x32x16_bf16(b, qr[d0], pk, 0, 0, 0); }
            if (HASR) {
#pragma unroll
                for (int d0 = 8; d0 < ND0; ++d0) { const int ch = (d0 - 8) * 2 + hi;
                    const bf16x8 b = *(const LAS bf16x8*)(Kb + 16384 + krow * 128 + ((ch ^ ((r32 >> 1) & 7)) << 4));
                    pk = __builtin_amdgcn_mfma_f32_32x32x16_bf16(b, qr[d0], pk, 0, 0, 0); } }
            if (BIAS) {
                const int rb = u.rb0 + u.rbstep * t + u.qi - 32 * wid;
#pragma unroll
                for (int r = 0; r < 16; ++r) { int i0 = rb - crow(r, hi); i0 = min(max(i0, -MAXREL), MAXREL) + MAXREL; pk[r] += bl[i0]; }
            }
            float ps = 0.f;
#pragma unroll
            for (int r = 0; r < 16; ++r) { pk[r] = __builtin_amdgcn_exp2f(pk[r]); ps += pk[r]; }
            l_reg += ps;
            bf16x8 pa0, pa1;
#define PK4(P, BASE, OUT) do { unsigned a0 = cvtpk(P[BASE + 0], P[BASE + 1]), a1 = cvtpk(P[BASE + 2], P[BASE + 3]); \
    unsigned b0_ = cvtpk(P[BASE + 4], P[BASE + 5]), b1_ = cvtpk(P[BASE + 6], P[BASE + 7]); \
    auto r0 = __builtin_amdgcn_permlane32_swap(a0, b0_, false, false); auto r1 = __builtin_amdgcn_permlane32_swap(a1, b1_, false, false); \
    u32x4 w = {r0[0], r1[0], r0[1], r1[1]}; OUT = __builtin_bit_cast(bf16x8, w); } while (0)
            PK4(pk, 0, pa0); PK4(pk, 8, pa1);
#undef PK4
            const int vb = vb0 + slot * VSLOT;
#define PV2(D0) do { const s16x4 l0 = tr_read<v_rd_off(D0, 0, 0)>(vb), h0 = tr_read<v_rd_off(D0, 0, 1)>(vb), l1 = tr_read<v_rd_off(D0, 1, 0)>(vb), h1 = tr_read<v_rd_off(D0, 1, 1)>(vb); \
        asm volatile("s_waitcnt lgkmcnt(0)" ::: "memory"); SBAR(); \
        o[D0] = __builtin_amdgcn_mfma_f32_32x32x16_bf16(pa0, ((bf16x8){l0[0], l0[1], l0[2], l0[3], h0[0], h0[1], h0[2], h0[3]}), o[D0], 0, 0, 0); \
        o[D0] = __builtin_amdgcn_mfma_f32_32x32x16_bf16(pa1, ((bf16x8){l1[0], l1[1], l1[2], l1[3], h1[0], h1[1], h1[2], h1[3]}), o[D0], 0, 0, 0); } while (0)
            PV2(0); PV2(1); PV2(2); PV2(3);
#undef PV2
        }
        slot = slot == 2 ? 0 : slot + 1;
    }
    asm volatile("s_waitcnt lgkmcnt(0)\n\ts_barrier" ::: "memory");
    LAS float* xo = (LAS float*)(lds + 16384);
    if (wid == 1) {
#pragma unroll
        for (int d0 = 0; d0 < 4; ++d0)
#pragma unroll
            for (int r = 0; r < 16; ++r) xo[(d0 * 16 + r) * 64 + lane] = o[d0][r];
        wsf[lane] = l_reg;
    }
    asm volatile("s_waitcnt lgkmcnt(0)\n\ts_barrier" ::: "memory");
    if (wid == 0) {
#pragma unroll
        for (int d0 = 0; d0 < 4; ++d0)
#pragma unroll
            for (int r = 0; r < 16; ++r) o[d0][r] += xo[(d0 * 16 + r) * 64 + lane];
        l_reg += ((LAS float*)(lds + L_WS) + 128)[lane];
        { auto rr = __builtin_amdgcn_permlane32_swap(__float_as_uint(l_reg), __float_as_uint(l_reg), false, false); l_reg = __uint_as_float(rr[0]) + __uint_as_float(rr[1]); }
        if (hi == 0) wsf[32 + r32] = l_reg; LDS_WAIT();
        LAS bf16_t* st = (LAS bf16_t*)(lds);
#pragma unroll
        for (int r = 0; r < 16; ++r) { const int orow = crow(r, hi); const float rl = __builtin_amdgcn_rcpf(wsf[32 + orow]);
#pragma unroll
            for (int d0 = 0; d0 < 4; ++d0) { const unsigned w = cvtpk(o[d0][r] * rl, 0.f); st[orow * 128 + d0 * 32 + r32] = (bf16_t)(w & 0xffffu); } }
        LDS_WAIT();
        bf16_t* Ow = u.O;
#pragma unroll
        for (int i = 0; i < 8; ++i) { const int row = i * 4 + (lane >> 4), ch = lane & 15; const u32x4 v = *(const LAS u32x4*)(st + row * 128 + ch * 8); *(u32x4*)(Ow + (size_t)row * u.ldo + ch * 8) = v; }
    }
    asm volatile("s_waitcnt lgkmcnt(0)\n\ts_barrier" ::: "memory");
#undef DMA_TILE
}
#undef SBAR
}

struct Args { const float* in[22]; float* out; unsigned char* ws; };
constexpr int LDS_BYTES = 147456;
constexpr int NWAVES = 8;
#ifndef PH
#define PH 1023
#endif
#ifndef SPLIT_IN
#define SPLIT_IN 0
#endif
#ifndef SPLIT_WO
#define SPLIT_WO 0
#endif
#ifndef SPLIT_UP
#define SPLIT_UP 0
#endif
#ifndef DBL
#define DBL 0
#endif
#define REP(bit) for (int rep_ = 0; rep_ < (((DBL) & (bit)) ? 2 : 1); ++rep_)
#ifndef SYNCS
#define SYNCS 1
#endif
#define GSYNC() do { for (int s_ = 0; s_ < SYNCS; ++s_) { unsigned* bw_ = (unsigned*)(KWS(kargs()) + WS_BAR); xcd_barrier(bw_, xcc, xst, wave, lane_now()); } } while (0)

__device__ __forceinline__ void transpose_item(const float* W, int ldw, int col0, bf16_t* WT, int ldt, int row0, int k0, LAS float* scr, int lane, const float* gk = nullptr, int ropeblk = -1) {
    if (col0 >= 0) {
        const int l = lane & 31, cofs = ropeblk < 0 ? l : 32 * ((l >> 2) & 1) + 16 * ropeblk + 4 * (l >> 3) + (l & 3);
#pragma unroll 8
        for (int i = 0; i < 32; ++i) { const int kk = 2 * i + (lane >> 5); float w = W[(size_t)(k0 + kk) * ldw + col0 + cofs]; if (gk) w *= gk[k0 + kk]; scr[kk * 33 + (lane & 31)] = w; }
    } else {
#pragma unroll 8
        for (int i = 0; i < 32; ++i) { const int kk = 2 * i + (lane >> 5); scr[kk * 33 + (lane & 31)] = 0.f; }
    }
    LDS_WAIT(); asm volatile("" ::: "memory");
    const int c = lane & 7;
#pragma unroll
    for (int j = 0; j < 4; ++j) { const int n = (lane >> 3) + 8 * j; const LAS float* s = scr + (8 * c) * 33 + n;
        u32x4 o; o.x = cvtpk(s[0 * 33], s[1 * 33]); o.y = cvtpk(s[2 * 33], s[3 * 33]); o.z = cvtpk(s[4 * 33], s[5 * 33]); o.w = cvtpk(s[6 * 33], s[7 * 33]);
        *(u32x4*)(WT + (size_t)(row0 + n) * ldt + k0 + 8 * c) = o; }
    LDS_WAIT(); asm volatile("" ::: "memory");
}
__device__ __forceinline__ void rms_row_2048(const float* xrow, const float* g, bf16_t* orow, int lane) {
    f32x4 v[8]; float s = 0.f;
#pragma unroll
    for (int j = 0; j < 8; ++j) { v[j] = *((const f32x4*)xrow + lane + 64 * j); s += (v[j].x * v[j].x + v[j].y * v[j].y) + (v[j].z * v[j].z + v[j].w * v[j].w); }
    const float rstd = rsqrtf(red64(s) * (1.f / 2048.f) + EPS);
#pragma unroll
    for (int j = 0; j < 8; ++j) { const f32x4 gg = *((const f32x4*)g + lane + 64 * j); u32x2 w; w.x = cvtpk(v[j].x * rstd * gg.x, v[j].y * rstd * gg.y); w.y = cvtpk(v[j].z * rstd * gg.z, v[j].w * rstd * gg.w);
        *((u32x2*)orow + lane + 64 * j) = w; }
}
template <class RowPtr>
__device__ __forceinline__ void rms_pass_2048(const RowPtr& rowptr, int nrows, const float* g, bf16_t* out, int gw, int NGW, int lane) {
    f32x4 nx[8], ny[8], gv[8];
#pragma unroll
    for (int j = 0; j < 8; ++j) gv[j] = *((const f32x4*)g + lane + 64 * j);
    if (gw < nrows) {
#pragma unroll
        for (int j = 0; j < 8; ++j) nx[j] = __builtin_nontemporal_load((const f32x4*)rowptr(gw) + lane + 64 * j); }
    if (gw + NGW < nrows) {
#pragma unroll
        for (int j = 0; j < 8; ++j) ny[j] = __builtin_nontemporal_load((const f32x4*)rowptr(gw + NGW) + lane + 64 * j); }
#define RMS_ROW(BUF, M) do { f32x4 v[8]; float s = 0.f; \
        _Pragma("unroll") for (int j = 0; j < 8; ++j) { v[j] = BUF[j]; s += (v[j].x * v[j].x + v[j].y * v[j].y) + (v[j].z * v[j].z + v[j].w * v[j].w); } \
        if ((M) + 2 * NGW < nrows) { _Pragma("unroll") for (int j = 0; j < 8; ++j) BUF[j] = __builtin_nontemporal_load((const f32x4*)rowptr((M) + 2 * NGW) + lane + 64 * j); } \
        const float rstd = rsqrtf(red64(s) * (1.f / 2048.f) + EPS); bf16_t* orow = out + (size_t)(M) * DM; \
        _Pragma("unroll") for (int j = 0; j < 8; ++j) { const f32x4 gg = gv[j]; u32x2 w; w.x = cvtpk(v[j].x * rstd * gg.x, v[j].y * rstd * gg.y); w.y = cvtpk(v[j].z * rstd * gg.z, v[j].w * rstd * gg.w); \
            *((u32x2*)orow + lane + 64 * j) = w; } } while (0)
    for (int m = gw; m < nrows; m += 2 * NGW) {
        RMS_ROW(nx, m);
        if (m + NGW < nrows) RMS_ROW(ny, m + NGW);
    }
#undef RMS_ROW
}
__device__ __forceinline__ void rms_pass_bf16_2048(const bf16_t* in, int nrows, const float* g, bf16_t* out, int gw, int NGW, int lane) {
    u32x4 nx[4];
    if (gw < nrows) {
#pragma unroll
        for (int j = 0; j < 4; ++j) nx[j] = *((const u32x4*)(in + (size_t)gw * DM) + lane + 64 * j); }
    for (int m = gw; m < nrows; m += NGW) {
        float v[4][8]; float s = 0.f;
#pragma unroll
        for (int j = 0; j < 4; ++j) { unpack8(nx[j], v[j]);
#pragma unroll
            for (int e = 0; e < 8; ++e) s += v[j][e] * v[j][e]; }
        if (m + NGW < nrows) {
#pragma unroll
            for (int j = 0; j < 4; ++j) nx[j] = *((const u32x4*)(in + (size_t)(m + NGW) * DM) + lane + 64 * j); }
        const float rstd = rsqrtf(red64(s) * (1.f / 2048.f) + EPS);
#pragma unroll
        for (int j = 0; j < 4; ++j) { float gg[8]; ld8f(g + (lane + 64 * j) * 8, gg); float o[8];
#pragma unroll
            for (int e = 0; e < 8; ++e) o[e] = v[j][e] * rstd * gg[e];
            *((u32x4*)(out + (size_t)m * DM) + lane + 64 * j) = pack8(o); }
    }
}
struct RowPtrX { const float* xp; const float* xs; __device__ __forceinline__ const float* operator()(int m) const { return m < MP ? xp + (size_t)m * DM : xs + (size_t)(m - MP) * DM; } };
struct RowPtrY { const float* y; __device__ __forceinline__ const float* operator()(int m) const { return y + (size_t)m * DM; } };
__device__ __forceinline__ void kpe_item(const float* v, int c8, int kvrow, int pos, bool valid, const float* g_ka, const float* ropetab, float* R, float* SSPE) {
    float ss = 0.f;
#pragma unroll
    for (int e = 0; e < 8; ++e) ss += v[e] * v[e];
    ss = red8(ss);
    float x[8], px[8];
#pragma unroll
    for (int e = 0; e < 8; ++e) x[e] = v[e] * g_ka[NOPE + 8 * c8 + e];
#pragma unroll
    for (int e = 0; e < 8; ++e) px[e] = __shfl_xor(x[e], 4);
    const int i0 = 8 * (c8 & 3);
    if (valid) {
        const float* ct = ropetab + (size_t)pos * 64 + i0; float o[8];
#pragma unroll
        for (int e = 0; e < 8; ++e) { const float c = ct[e], s = ct[32 + e]; o[e] = (c8 < 4) ? (x[e] * c - px[e] * s) : (px[e] * s + x[e] * c); }
        const int p0 = 32 * ((c8 >> 1) & 1) + 16 * (c8 & 1) + 4 * (c8 >> 2);
        *(f32x4*)(R + (size_t)kvrow * 64 + p0) = (f32x4){o[0], o[1], o[2], o[3]}; *(f32x4*)(R + (size_t)kvrow * 64 + p0 + 8) = (f32x4){o[4], o[5], o[6], o[7]};
        if (c8 == 0) SSPE[kvrow] = ss;
    }
}


#define RLX_AGENT __ATOMIC_RELAXED, __HIP_MEMORY_SCOPE_AGENT
#define XB_TMO      128
#define XB_XCNT(j)  (256  + 64 * (j))
#define XB_XSUB(j)  (1280 + 64 * (j))
#define XB_XGEN(j)  (2304 + 64 * (j))
#define XB_TOP      3328
#define XB_TOPGEN   3392
#define XCD_BAR_WORDS 3456
#define XB_SPIN_CAP (1u << 20)
__device__ __forceinline__ unsigned xb_ld(unsigned* p)              { return __hip_atomic_load(p, __ATOMIC_RELAXED, __HIP_MEMORY_SCOPE_AGENT); }
__device__ __forceinline__ unsigned xb_add(unsigned* p, unsigned v) { return __hip_atomic_fetch_add(p, v, __ATOMIC_RELAXED, __HIP_MEMORY_SCOPE_AGENT); }
__device__ __forceinline__ unsigned xb_xcc_id() { return (unsigned)__builtin_amdgcn_s_getreg((3 << 11) | 20) & 0xFu; }
#define XB_SPIN(cond, bar) do { unsigned _sp = 0; while (cond) { __builtin_amdgcn_s_sleep(1); \
    if ((++_sp & 255u) == 0u) { if (xb_ld(&(bar)[XB_TMO])) break; if (_sp > XB_SPIN_CAP) { atomicAdd(&(bar)[XB_TMO], 1u); break; } } } } while (0)
__device__ __forceinline__ void xcd_barrier_complete(unsigned* bar, unsigned x, unsigned& nloc, unsigned& nx) {
    const unsigned G = gridDim.x * gridDim.y * gridDim.z;
    unsigned sum, cnt, mine, sp = 0u;
    for (;;) {
        sum = 0u; cnt = 0u; mine = 0u;
#pragma unroll
        for (unsigned j = 0; j < 16; ++j) { const unsigned c = xb_ld(&bar[XB_XCNT(j)]); sum += c; cnt += (c > 0u) ? 1u : 0u; mine = (j == x) ? c : mine; }
        if (sum == G) break;
        __builtin_amdgcn_s_sleep(1);
        if ((++sp & 255u) == 0u) { if (xb_ld(&bar[XB_TMO])) break; if (sp > XB_SPIN_CAP) { atomicAdd(&bar[XB_TMO], 1u); break; } }
    }
    nloc = mine > 0u ? mine : 1u; nx = cnt > 0u ? cnt : 1u;
}
__device__ __forceinline__ void xcd_barrier(unsigned* bar, unsigned x, volatile LAS unsigned* st, const int wave, const int lane) {
    asm volatile("s_waitcnt vmcnt(0)" ::: "memory");
    __syncthreads();
    if (wave == 0 && lane == 0) {
        __builtin_amdgcn_s_waitcnt(0);
        unsigned nloc = st[0], nx = st[1];
        if (nloc == 0u) { xcd_barrier_complete(bar, x, nloc, nx); st[0] = nloc; st[1] = nx; }
        const unsigned old = xb_add(&bar[XB_XSUB(x)], 1u);
        const unsigned gen = old / nloc;
        if (old + 1u == (gen + 1u) * nloc) {
            __builtin_amdgcn_fence(__ATOMIC_RELEASE, "agent");
            asm volatile("s_waitcnt vmcnt(0)" ::: "memory");
            const unsigned og = xb_add(&bar[XB_TOP], 1u);
            const unsigned tg = og / nx;
            if (og + 1u == (tg + 1u) * nx) xb_add(&bar[XB_TOPGEN], 1u);
            else XB_SPIN(xb_ld(&bar[XB_TOPGEN]) == tg, bar);
            __builtin_amdgcn_fence(__ATOMIC_ACQUIRE, "agent");
            xb_add(&bar[XB_XGEN(x)], 1u);
            asm volatile("s_waitcnt vmcnt(0)" ::: "memory");
        } else {
            XB_SPIN(xb_ld(&bar[XB_XGEN(x)]) == gen, bar);
            __builtin_amdgcn_fence(__ATOMIC_ACQUIRE, "agent");
            asm volatile("s_waitcnt vmcnt(0)" ::: "memory");
        }
    }
    __syncthreads();
}
constexpr int MISC_OFF = 147456 - 64;
constexpr size_t WS_BAR = 4096 * 4;
typedef const unsigned char __attribute__((address_space(4)))* kptr_t;
__device__ __forceinline__ kptr_t kargs() { kptr_t p = (kptr_t)__builtin_amdgcn_kernarg_segment_ptr(); asm volatile("" : "+s"(p)); return p; }
#define KIN(ka, i) (*(const float* const __attribute__((address_space(4)))*)((ka) + 8 * (i)))
#define KOUT(ka) (*(float* const __attribute__((address_space(4)))*)((ka) + 176))
#define KWS(ka) (*(unsigned char* const __attribute__((address_space(4)))*)((ka) + 184))
enum { I_XP = 0, I_XS, I_CCKV, I_CKPE, I_CBK, I_CBV, I_NMIX, I_WIN, I_GCQ, I_WUQ, I_GCKV, I_WUK, I_WUV, I_GQA, I_GKA, I_GQB, I_GKB, I_RELB, I_WO, I_NFFN, I_WUP, I_WDN };


constexpr int CW_SPLIT = 8192;
template <int S>
__device__ __forceinline__ void sample_split_unit(LAS unsigned char* lds, const bf16_t* A  , int lda, const bf16_t* Bt, int ldb, int N, int K, float* slab, unsigned* cnt, int vcu, int wave) {
    const int nN = N / 256, NSUB = 2 * nN * S, Ksub = K / S;
    if (vcu < NSUB) {
        const int ks = vcu % S, tile = vcu / S, pm = tile / nN, pn = tile % nN;
        pg8::Gemm g{A + (size_t)ks * Ksub, Bt + (size_t)ks * Ksub, 512, N, Ksub, lda, ldb}; pg8::OneUnit S1{pm, pn, true};
        pg8::EpiSlab E{slab + (size_t)ks * 2 * nN * 65536, nN}; pg8::gemm_phase(lds, g, S1, E, wave);
        asm volatile("s_waitcnt vmcnt(0)" ::: "memory");
        __syncthreads();
        if (wave == 0 && lane_now() == 0) (void)xb_add(cnt, 1u);
    }
}
__device__ __forceinline__ void sample_wait(unsigned* cnt, unsigned want, unsigned* tmo, int wave) {
    if (wave == 0) { if (lane_now() == 0) { XB_SPIN(xb_ld(cnt) < want, tmo - XB_TMO); } __builtin_amdgcn_fence(__ATOMIC_ACQUIRE, "agent"); asm volatile("s_waitcnt vmcnt(0)" ::: "memory"); }
    __syncthreads();
    __builtin_amdgcn_fence(__ATOMIC_ACQUIRE, "agent"); asm volatile("s_waitcnt vmcnt(0)" ::: "memory");
}
struct UpOrder { pg8::StaticOrder S; unsigned* cnt; unsigned* bar;
    __device__ bool next(int i, pg8::Unit& u) const { if (!S.next(i, u)) return false;
        if (u.pm >= MP / 256) { if (lane_now() == 0) { XB_SPIN(xb_ld(cnt) < 16u, bar); } __builtin_amdgcn_fence(__ATOMIC_ACQUIRE, "agent"); asm volatile("s_waitcnt vmcnt(0)" ::: "memory"); }
        return true; } };
template <int S>
__device__ __forceinline__ f32x4 slab_sum(const float* slab, int nN, int r, int c) {
    const float* p = slab + ((size_t)((r >> 8) * nN + (c >> 8)) * 256 + (r & 255)) * 256 + (c & 255);
    f32x4 s = *(const f32x4*)p;
#pragma unroll
    for (int k = 1; k < S; ++k) s += *(const f32x4*)(p + (size_t)k * 2 * nN * 65536);
    return s;
}
template <int S, class F>
__device__ __forceinline__ void sample_reduce(const float* slab, int N, unsigned* cnt, unsigned* bar, int vcu, int wave, const F& f) {
    sample_wait(cnt, (unsigned)(2 * (N / 256) * S), bar + XB_TMO, wave);
    const int lane = lane_now(), r = 2 * vcu + (wave >> 2);
    for (int c4 = lane; c4 < N / 16; c4 += 64) { const int c = (wave & 3) * (N / 4) + c4 * 4; f(r, c, slab_sum<S>(slab, N / 256, r, c)); }
}
struct RedBf16 { bf16_t* O; int ldc;
    __device__ __forceinline__ void operator()(int r, int c, f32x4 s) const { u32x2 w; w.x = cvtpk(s[0], s[1]); w.y = cvtpk(s[2], s[3]); *(u32x2*)(O + (size_t)r * ldc + c) = w; } };
struct RedRelu2 { bf16_t* O; int ldc;
    __device__ __forceinline__ void operator()(int r, int c, f32x4 s) const { float a[4];
#pragma unroll
        for (int e = 0; e < 4; ++e) { const float t = fmaxf(s[e], 0.f); a[e] = t * t; }
        u32x2 w; w.x = cvtpk(a[0], a[1]); w.y = cvtpk(a[2], a[3]); *(u32x2*)(O + (size_t)r * ldc + c) = w; } };
struct RedResBf16 { const float* base; bf16_t* out;
    __device__ __forceinline__ void operator()(int r, int c, f32x4 s) const { const f32x4 h = *(const f32x4*)(base + (size_t)r * DM + c) + s; u32x2 w; w.x = cvtpk(h[0], h[1]); w.y = cvtpk(h[2], h[3]); *(u32x2*)(out + (size_t)r * DM + c) = w; } };
struct RedResF32 { const float* base; float* out;
    __device__ __forceinline__ void operator()(int r, int c, f32x4 s) const { *(f32x4*)(out + (size_t)r * DM + c) = *(const f32x4*)(base + (size_t)r * DM + c) + s; } };

__global__ void __launch_bounds__(NWAVES * 64, 2) mk_fwd(Args args) {
    extern __shared__ __attribute__((aligned(16))) unsigned char lds_raw[];
    LAS unsigned char* lds = (LAS unsigned char*)lds_raw;
    cg::grid_group grid = cg::this_grid();
    const int wave = __builtin_amdgcn_readfirstlane((int)(threadIdx.x >> 6));
    const int G = gridDim.x, bx = blockIdx.x, vcu = (G % 8 == 0) ? (bx % 8) * (G / 8) + bx / 8 : bx;
    const int gw = vcu * NWAVES + wave, NGW = G * NWAVES;
    volatile LAS unsigned* xst = (volatile LAS unsigned*)(lds + MISC_OFF);
    { const int lane = lane_now(); if (wave == 0 && lane < 2) xst[lane] = 0u;
      if (bx == 0) { unsigned* bw = (unsigned*)(KWS(kargs()) + WS_BAR); for (int i = wave * 64 + lane; i < XCD_BAR_WORDS; i += NWAVES * 64) bw[i] = 0u;
                     if (wave == 0 && lane < 5) ((unsigned*)KWS(kargs()))[CW_SPLIT + 64 * lane] = 0u; } }
    const unsigned xcc = xb_xcc_id();

    REP(1) if (PH & 1) {
        kptr_t ka = kargs(); unsigned char* ws = KWS(ka); const int lane = lane_now();
        LAS float* scr = (LAS float*)(lds + wave * 16384);
        bf16_t* WIN = (bf16_t*)(ws + WS_WIN);
        constexpr int I_IN = (DM / 64) * (NCP / 32);
        for (int it = gw; it < I_IN; it += NGW) { const int nb = it % (NCP / 32), kb = it / (NCP / 32), n0 = nb * 32;
            const bool isk = n0 >= CC_KPE && n0 < CC_KPE + 64;
            const int col0 = n0 < CC_QB ? n0 : (n0 < CC_KPE ? n0 + 64 : (isk ? 768 : -1));
            transpose_item(KIN(ka, I_WIN), INC, col0, WIN, DM, n0, kb * 64, scr, lane, nullptr, isk ? (n0 - CC_KPE) / 32 : -1); }
        { bf16_t* XN = (bf16_t*)(ws + WS_XN); const float* xp = KIN(ka, I_XP); const float* xs = KIN(ka, I_XS); const float* nm = KIN(ka, I_NMIX);
          RowPtrX rp{xp, xs}; rms_pass_2048(rp, MT, nm, XN, gw, NGW, lane); }
        { float* ROPET = (float*)(ws + WS_ROPE);
          for (int i = gw * 64 + lane; i < SEQ * 32; i += NGW * 64) { const int pos = i >> 5, k = i & 31;
            const float inv = 1.0f / powf(10000.0f, (float)(2 * k) / 64.0f); const float ang = (float)pos * inv;
            const double a = (double)ang; ROPET[(size_t)pos * 64 + k] = (float)cos(a); ROPET[(size_t)pos * 64 + 32 + k] = (float)sin(a); } }
    }
    grid.sync();
    { unsigned* bw_ = (unsigned*)(KWS(kargs()) + WS_BAR); if (wave == 0 && lane_now() == 0) (void)xb_add(&bw_[XB_XCNT(xcc)], 1u); }
    REP(2) if (PH & 2) {
      if (SPLIT_IN) { kptr_t ka = kargs(); unsigned char* ws = KWS(ka);
        sample_split_unit<8>(lds, (const bf16_t*)(ws + WS_XN) + (size_t)MP * DM, DM, (const bf16_t*)(ws + WS_WIN), DM, NCP, DM, (float*)(ws + WS_SLAB1), (unsigned*)ws + CW_SPLIT + 64 * 0, vcu, wave); }
      { kptr_t ka = kargs(); unsigned char* ws = KWS(ka);
        pg8::Gemm g{(const bf16_t*)(ws + WS_XN), (const bf16_t*)(ws + WS_WIN), MP, NCP, DM, DM, DM}; pg8::StaticOrder S; S.init(SPLIT_IN ? MP : MT, NCP, G, bx);
        pg8::EpiInproj E{(bf16_t*)((unsigned char*)KOUT(ka) + OS_C2), (bf16_t*)(ws + WS_QB), (bf16_t*)(ws + WS_KBP), (bf16_t*)(ws + WS_KBS), (bf16_t*)(ws + WS_VBP), (bf16_t*)(ws + WS_VBS), KOUT(ka), KIN(ka, I_GQB), KIN(ka, I_GKB), KIN(ka, I_GCKV), (bf16_t*)(ws + WS_CKV), (float*)(ws + WS_PCQ), KIN(ka, I_GKA), (const float*)(ws + WS_ROPE), (float*)((unsigned char*)KOUT(ka) + OS_R), (float*)((unsigned char*)KOUT(ka) + OS_SSPE), lds + 131072}; pg8::gemm_phase(lds, g, S, E, wave); }
      { const int nwg_ = ((SPLIT_IN ? MP : MT) / 256) * (NCP / 256), ntail = nwg_ % G;
        if (ntail > 0 && bx >= ntail) {
          kptr_t ka = kargs(); unsigned char* ws = KWS(ka); unsigned char* os = (unsigned char*)KOUT(ka); const int lane = lane_now();
          const int gwx = (bx - ntail) * NWAVES + wave, NGWX = (G - ntail) * NWAVES;
          LAS float* scr = (LAS float*)(lds + wave * 16384);
          bf16_t* WUQ = (bf16_t*)(ws + WS_WUQ); bf16_t* WUKV = (bf16_t*)(ws + WS_WUKV); bf16_t* WO = (bf16_t*)(ws + WS_WO);
          constexpr int I_UQ = (QLORA / 64) * (2048 / 32), I_UK = (KVLORA / 64) * (1024 / 32), I_UV = I_UK, I_O = (DM / 64) * (DM / 32);
          constexpr int NITEMS = I_UQ + I_UK + I_UV + I_O;
          for (int it = gwx; it < NITEMS; it += NGWX) {
            int r = it;
            if (r < I_UQ) { const int nb = r % 64, kb = r / 64, h = nb >> 3, b8 = nb & 7;
                const int col0 = b8 < 4 ? h * QKA + b8 * 32 : (b8 < 6 ? h * QKA + NOPE : -1);
                transpose_item(KIN(ka, I_WUQ), 1536, col0, WUQ, QLORA, nb * 32, kb * 64, scr, lane, KIN(ka, I_GCQ), (b8 == 4 || b8 == 5) ? b8 - 4 : -1); continue; } r -= I_UQ;
            if (r < I_UK) { const int nb = r % 32, kb = r / 32; transpose_item(KIN(ka, I_WUK), 1024, nb * 32, WUKV, KVLORA, nb * 32, kb * 64, scr, lane); continue; } r -= I_UK;
            if (r < I_UV) { const int nb = r % 32, kb = r / 32; transpose_item(KIN(ka, I_WUV), 1024, nb * 32, WUKV, KVLORA, 1024 + nb * 32, kb * 64, scr, lane); continue; } r -= I_UV;
            { const int nb = r % 64, kb = r / 64; transpose_item(KIN(ka, I_WO), DM, nb * 32, WO, DM, nb * 32, kb * 64, scr, lane); }
          }
          const int gw = gwx, NGW = NGWX;
          { bf16_t* CKV = (bf16_t*)(ws + WS_CKV); const float* cc = KIN(ka, I_CCKV);
            for (int rr = gw; rr < DECB * PAST; rr += NGW) { const int s = rr / PAST, p = rr % PAST; const f32x4 v = *((const f32x4*)(cc + (size_t)rr * KVLORA) + lane);
              u32x2 w; w.x = cvtpk(v.x, v.y); w.y = cvtpk(v.z, v.w); *((u32x2*)(CKV + (size_t)(MP + s * KVLEN + p) * KVLORA) + lane) = w; } }
          { bf16_t* KBS = (bf16_t*)(ws + WS_KBS); bf16_t* VBS = (bf16_t*)(ws + WS_VBS); const float* cbk = KIN(ka, I_CBK); const float* cbv = KIN(ka, I_CBV);
            for (int rr = gw; rr < DECB * BANDL; rr += NGW) { const int s = rr / BANDL, p = rr % BANDL; const size_t dst = (size_t)(s * BLEN + p) * 1024;
#pragma unroll
              for (int j = 0; j < 4; ++j) { const f32x4 a = *((const f32x4*)(cbk + (size_t)rr * 1024) + lane + 64 * j), b = *((const f32x4*)(cbv + (size_t)rr * 1024) + lane + 64 * j);
                  u32x2 wa, wb; wa.x = cvtpk(a.x, a.y); wa.y = cvtpk(a.z, a.w); wb.x = cvtpk(b.x, b.y); wb.y = cvtpk(b.z, b.w);
                  *((u32x2*)(KBS + dst) + lane + 64 * j) = wa; *((u32x2*)(VBS + dst) + lane + 64 * j) = wb; } } }

          { const float* ROPET = (const float*)(ws + WS_ROPE); float* R = (float*)(os + OS_R); float* SSPE = (float*)(os + OS_SSPE); const float* ck = KIN(ka, I_CKPE); const float* gka = KIN(ka, I_GKA);
            for (int it = gw; it < DECB * PAST / 8; it += NGW) { const int rr = it * 8 + (lane >> 3), c8 = lane & 7, s = rr / PAST, p = rr % PAST;
              const float* src = ck + (size_t)rr * ROPE + 8 * c8; const f32x4 a = *(const f32x4*)src, b = *(const f32x4*)(src + 4);
              const float v[8] = {a.x, a.y, a.z, a.w, b.x, b.y, b.z, b.w};
              kpe_item(v, c8, MP + s * KVLEN + p, p, true, gka, ROPET, R, SSPE); } }
        } }
      if (SPLIT_IN) { kptr_t ka = kargs(); unsigned char* ws = KWS(ka);
        RedBf16 f{(bf16_t*)(ws + WS_C) + (size_t)MP * NCP, NCP};
        sample_reduce<8>((const float*)(ws + WS_SLAB1), NCP, (unsigned*)ws + CW_SPLIT + 64 * 0, (unsigned*)(ws + WS_BAR), vcu, wave, f); }
    }
    GSYNC();

    REP(8) if (PH & 8) { kptr_t ka = kargs(); unsigned char* ws = KWS(ka); unsigned char* os = (unsigned char*)KOUT(ka);
      pg8::Gemm g{(const bf16_t*)(os + OS_C2), (const bf16_t*)(ws + WS_WUQ), MT, 2048, QLORA, CP, QLORA}; pg8::StaticOrder S; S.init(MT, 2048, G, bx);
      pg8::EpiQ E{(bf16_t*)(ws + WS_Q), (const float*)(ws + WS_PCQ), KIN(ka, I_GQA), (const float*)(ws + WS_ROPE), lds + 131072}; pg8::gemm_phase(lds, g, S, E, wave); }
    REP(1024) if (PH & 8) { kptr_t ka = kargs(); unsigned char* ws = KWS(ka);
      pg8::Gemm g{(const bf16_t*)(ws + WS_CKV), (const bf16_t*)(ws + WS_WUKV), KVROWS, 2048, KVLORA, KVLORA, KVLORA}; pg8::StaticOrder S; S.init(KVROWS, 2048, G, G - 1 - bx);
      unsigned char* os = (unsigned char*)KOUT(ka);
      pg8::EpiKV E{os, ws, KIN(ka, I_GKA), lds + 131072}; pg8::gemm_phase(lds, g, S, E, wave); }
    GSYNC();

    REP(32) if ((PH & 32) && G == 256) {
        att::UnitDesc u; const int lane = lane_now();
        for (int k = 0; k < 2; ++k) { kptr_t ka = kargs(); unsigned char* ws = KWS(ka); unsigned char* os = (unsigned char*)KOUT(ka);
            const bf16_t* Q = (const bf16_t*)(ws + WS_Q); const bf16_t* KM = (const bf16_t*)(os + OS_K); const bf16_t* VM = (const bf16_t*)(ws + WS_XN); bf16_t* AO = (bf16_t*)(ws + WS_AO);
            const int bh = vcu >> 4, b = bh >> 3, h = bh & 7, s = vcu & 15;
            const int qb = k == 0 ? 31 - s : s; const size_t row0 = (size_t)b * SEQ + qb * 256;
            u.Q = Q + row0 * 1536 + h * QKA; u.ldq = 1536; u.K = KM + (size_t)b * SEQ * 1536 + h * QKA; u.ldk = 1536; u.V = VM + (size_t)b * SEQ * 1024 + h * VA; u.ldv = 1024;
            u.O = AO + row0 * DM + h * VA; u.ldo = DM; u.t0 = 0; u.t1 = 4 * qb + 4; u.wlo = 0; u.whi = 4 * qb + (wave >> 1); u.half_last = 0; u.rb0 = 0; u.rbstep = 0; u.qi = 0;
            att::attn_unit<192, false>(u, lds, nullptr, wave); }
        for (int k = 0; k < 2; ++k) { kptr_t ka = kargs(); unsigned char* ws = KWS(ka);
            const bf16_t* QB = (const bf16_t*)(ws + WS_QB); const bf16_t* KBP = (const bf16_t*)(ws + WS_KBP); const bf16_t* VBP = (const bf16_t*)(ws + WS_VBP); bf16_t* AO = (bf16_t*)(ws + WS_AO);
            const int id = 2 * vcu + k, qb = id & 31, hh = (id >> 5) & 7, bb = id >> 8; const size_t row0 = (size_t)bb * SEQ + qb * 256;
            const int cq = 4 * qb + (wave >> 1);
            u.Q = QB + row0 * 1024 + hh * DHB; u.ldq = 1024; u.K = KBP + (size_t)bb * SEQ * 1024 + hh * DHB; u.ldk = 1024; u.V = VBP + (size_t)bb * SEQ * 1024 + hh * DHB; u.ldv = 1024;
            u.O = AO + row0 * DM + 1024 + hh * DHB; u.ldo = DM; u.t0 = max(0, 4 * qb - 8); u.t1 = 4 * qb + 4; u.wlo = max(0, cq - 8); u.whi = cq; u.half_last = 0;
            u.rb0 = 64 * cq; u.rbstep = -64; u.qi = 32 * (wave & 1) + (lane & 31);
            att::attn_unit<128, true>(u, lds, KIN(ka, I_RELB) + hh * NREL, wave); }
        if (vcu < 128) { kptr_t ka = kargs(); unsigned char* ws = KWS(ka); unsigned char* os = (unsigned char*)KOUT(ka);
            const bf16_t* Q = (const bf16_t*)(ws + WS_Q); const bf16_t* KM = (const bf16_t*)(os + OS_K); const bf16_t* VM = (const bf16_t*)(ws + WS_XN); bf16_t* AO = (bf16_t*)(ws + WS_AO);
            const int s = vcu >> 3, h = vcu & 7; const size_t row0 = (size_t)MP + s * DECS;
            u.Q = Q + row0 * 1536 + h * QKA; u.ldq = 1536; u.K = KM + (size_t)(MP + s * KVLEN) * 1536 + h * QKA; u.ldk = 1536; u.V = VM + (size_t)(MP + s * KVLEN) * 1024 + h * VA; u.ldv = 1024;
            u.O = (bf16_t*)(ws + WS_AOS) + (row0 - MP) * DM + h * VA; u.ldo = DM; u.t0 = 0; u.t1 = 17; u.wlo = wave == 0 ? 0 : 1; u.whi = wave == 0 ? 16 : 0; u.half_last = 1; u.rb0 = 0; u.rbstep = 0; u.qi = 0;
            att::attn_unit_ks<192, false>(u, lds, nullptr, wave);
        } else { kptr_t ka = kargs(); unsigned char* ws = KWS(ka);
            const bf16_t* QB = (const bf16_t*)(ws + WS_QB); const bf16_t* KBS = (const bf16_t*)(ws + WS_KBS); const bf16_t* VBS = (const bf16_t*)(ws + WS_VBS); bf16_t* AO = (bf16_t*)(ws + WS_AO);
            const int s = (vcu - 128) >> 3, h = vcu & 7; const size_t row0 = (size_t)MP + s * DECS;
            u.Q = QB + row0 * 1024 + h * DHB; u.ldq = 1024; u.K = KBS + (size_t)(s * BLEN) * 1024 + h * DHB; u.ldk = 1024; u.V = VBS + (size_t)(s * BLEN) * 1024 + h * DHB; u.ldv = 1024;
            u.O = (bf16_t*)(ws + WS_AOS) + (row0 - MP) * DM + 1024 + h * DHB; u.ldo = DM; u.t0 = 0; u.t1 = 9; u.wlo = wave == 0 ? 0 : 1; u.whi = wave == 0 ? 8 : 0; u.half_last = 1;
            u.rb0 = BANDL; u.rbstep = -64; u.qi = lane & 31;
            att::attn_unit_ks<128, true>(u, lds, KIN(ka, I_RELB) + h * NREL, wave); }
    }
    GSYNC();

    REP(64) if (PH & 64) {
      if (SPLIT_WO) { kptr_t ka = kargs(); unsigned char* ws = KWS(ka);
        sample_split_unit<8>(lds, (const bf16_t*)(ws + WS_AO) + (size_t)MP * DM, DM, (const bf16_t*)(ws + WS_WO), DM, DM, DM, (float*)(ws + WS_SLAB4), (unsigned*)ws + CW_SPLIT + 64 * 1, vcu, wave); }
      { kptr_t ka = kargs(); unsigned char* ws = KWS(ka);
        pg8::Gemm g{(const bf16_t*)(ws + WS_AO), (const bf16_t*)(ws + WS_WO), MP, DM, DM, DM, DM}; pg8::StaticOrder S; S.init(MP, DM, G, bx);
        pg8::EpiResBf16 E{KIN(ka, I_XP), nullptr, (bf16_t*)(ws + WS_HB), (float*)(ws + WS_SSP)}; pg8::gemm_phase(lds, g, S, E, wave); }
      { kptr_t ka = kargs(); unsigned char* ws = KWS(ka); const int lane = lane_now(); LAS float* scr = (LAS float*)(lds + wave * 16384); bf16_t* WUP = (bf16_t*)(ws + WS_WUP);
        __syncthreads();
        for (int r = bx * NWAVES + wave; r < (DM / 64) * (DFF / 32); r += G * NWAVES) { const int nb = r % 256, kb = r / 256; transpose_item(KIN(ka, I_WUP), DFF, nb * 32, WUP, DM, nb * 32, kb * 64, scr, lane, KIN(ka, I_NFFN)); } }
      if (SPLIT_WO) { kptr_t ka = kargs(); unsigned char* ws = KWS(ka);
        RedResBf16 f{KIN(ka, I_XS), (bf16_t*)(ws + WS_HB) + (size_t)MP * DM};
        sample_reduce<8>((const float*)(ws + WS_SLAB4), DM, (unsigned*)ws + CW_SPLIT + 64 * 1, (unsigned*)(ws + WS_BAR), vcu, wave, f); }
    }
    GSYNC();
    { kptr_t ka = kargs(); unsigned char* ws = KWS(ka); const int lane = lane_now(); const float* PHs = (const float*)(ws + WS_SSP); float* RS2 = (float*)(ws + WS_SSP + 3 * MiB);
      for (int r = gw * 64 + lane; r < MP; r += NGW * 64) { float s = 0.f;
#pragma unroll
        for (int j = 0; j < 8; ++j) { const f32x4 p = *(const f32x4*)(PHs + (size_t)r * 32 + 4 * j); s += (p[0] + p[1]) + (p[2] + p[3]); }
        RS2[r] = 1.0f / (s * (1.f / 2048.f) + EPS); } }
    REP(256) if (PH & 256) {
      if (SPLIT_UP) { kptr_t ka = kargs(); unsigned char* ws = KWS(ka);
        sample_split_unit<4>(lds, (const bf16_t*)(ws + WS_XN) + (size_t)MP * DM, DM, (const bf16_t*)(ws + WS_WUP), DM, DFF, DM, (float*)(ws + WS_SLAB), (unsigned*)ws + CW_SPLIT + 64 * 2, vcu, wave); }
      if (bx >= 64 && bx < 80) { kptr_t ka = kargs(); unsigned char* ws = KWS(ka);
        const int j = bx - 64; pg8::Gemm g{(const bf16_t*)(ws + WS_AOS) - (size_t)MP * DM, (const bf16_t*)(ws + WS_WO), MT, DM, DM, DM, DM};   pg8::OneUnit S1{MP / 256 + (j >> 3), j & 7, true};
        pg8::EpiResBf16 E{KIN(ka, I_XP), KIN(ka, I_XS), (bf16_t*)(ws + WS_HB), (float*)(ws + WS_SSP)}; pg8::gemm_phase(lds, g, S1, E, wave);
        asm volatile("s_waitcnt vmcnt(0)" ::: "memory");
        __syncthreads();
        if (wave == 0 && lane_now() == 0) { __builtin_amdgcn_fence(__ATOMIC_RELEASE, "agent"); asm volatile("s_waitcnt vmcnt(0)" ::: "memory"); (void)xb_add((unsigned*)ws + CW_SPLIT + 64 * 4, 1u); }
        __syncthreads(); }
      { kptr_t ka = kargs(); unsigned char* ws = KWS(ka);
        pg8::Gemm g{(const bf16_t*)(ws + WS_HB), (const bf16_t*)(ws + WS_WUP), MP, DFF, DM, DM, DM}; UpOrder S; S.S.init(MT, DFF, G, bx); S.cnt = (unsigned*)ws + CW_SPLIT + 64 * 4; S.bar = (unsigned*)(ws + WS_BAR);
        pg8::EpiBf16<1> E{(bf16_t*)(ws + WS_U), PU, 0, 0}; pg8::gemm_phase(lds, g, S, E, wave); }
      { const int ntail = 80;
        if (bx >= ntail) { kptr_t ka = kargs(); unsigned char* ws = KWS(ka); const int lane = lane_now(); LAS float* scr = (LAS float*)(lds + wave * 16384); bf16_t* WDN = (bf16_t*)(ws + WS_WDN);
          for (int r = (bx - ntail) * NWAVES + wave; r < (DFF / 64) * (DM / 32); r += (G - ntail) * NWAVES) { const int nb = r % 64, kb = r / 64; transpose_item(KIN(ka, I_WDN), DM, nb * 32, WDN, PU, nb * 32, kb * 64, scr, lane); } } }
      if (SPLIT_UP) { kptr_t ka = kargs(); unsigned char* ws = KWS(ka);
        RedRelu2 f{(bf16_t*)(ws + WS_U) + (size_t)MP * PU, PU};
        sample_reduce<4>((const float*)(ws + WS_SLAB), DFF, (unsigned*)ws + CW_SPLIT + 64 * 2, (unsigned*)(ws + WS_BAR), vcu, wave, f); }
    }
    GSYNC();
    if (PH & 512) {
      { kptr_t ka = kargs(); unsigned char* ws = KWS(ka);
        sample_split_unit<16>(lds, (const bf16_t*)(ws + WS_U) + (size_t)MP * PU, PU, (const bf16_t*)(ws + WS_WDN), PU, DM, DFF, (float*)(ws + WS_SLAB), (unsigned*)ws + CW_SPLIT + 64 * 3, vcu, wave); }
#if (DBL) & 512
      { kptr_t ka = kargs(); unsigned char* ws = KWS(ka);
        pg8::Gemm g{(const bf16_t*)(ws + WS_U), (const bf16_t*)(ws + WS_WDN), MP, DM, DFF, PU, PU}; pg8::StaticOrder S; S.init(MP, DM, G, bx);
        pg8::EpiSlab E{(float*)(ws + WS_XN) + (size_t)bx * 65536, 0}; pg8::gemm_phase(lds, g, S, E, wave); }
#endif
      { kptr_t ka = kargs(); unsigned char* ws = KWS(ka); float* Y = KOUT(ka) + O_Y;
        pg8::Gemm g{(const bf16_t*)(ws + WS_U), (const bf16_t*)(ws + WS_WDN), MP, DM, DFF, PU, PU}; pg8::StaticOrder S; S.init(MP, DM, G, bx);
        pg8::EpiAddBf16 E{(const bf16_t*)(ws + WS_HB), Y, (const float*)(ws + WS_SSP + 3 * MiB)}; pg8::gemm_phase(lds, g, S, E, wave); }
      { kptr_t ka = kargs(); unsigned char* ws = KWS(ka); float* Y = KOUT(ka) + O_Y + (size_t)MP * DM; const float* slab = (const float*)(ws + WS_SLAB); const int lane = lane_now();
        sample_wait((unsigned*)ws + CW_SPLIT + 64 * 3, 2 * (DM / 256) * 16, (unsigned*)(ws + WS_BAR) + XB_TMO, wave);
        const int r = 2 * vcu + (wave >> 2); float rs2;
        { const float* PHs = (const float*)(ws + WS_SSP) + (size_t)(MP + r) * 32; float sq = 0.f;
#pragma unroll
          for (int jj = 0; jj < 8; ++jj) { const f32x4 pv = *(const f32x4*)(PHs + 4 * jj); sq += (pv[0] + pv[1]) + (pv[2] + pv[3]); }
          rs2 = 1.0f / (sq * (1.f / 2048.f) + EPS); }
        const bf16_t* hbs = (const bf16_t*)(ws + WS_HB) + (size_t)MP * DM;
        for (int c4 = lane; c4 < DM / 16; c4 += 64) { const int c = (wave & 3) * (DM / 4) + c4 * 4; const u32x2 hw = *(const u32x2*)(hbs + (size_t)r * DM + c); const f32x4 h = {bflo(hw.x), bfhi(hw.x), bflo(hw.y), bfhi(hw.y)};
            *(f32x4*)(Y + (size_t)r * DM + c) = h + slab_sum<16>(slab, DM / 256, r, c) * rs2; } }
    }
}

extern "C" void kernel_launch(void* const* d_in, const int* in_sizes, int n_in, void* d_out, int out_size, void* d_ws, size_t ws_size, hipStream_t stream) {
    static int grid = 0;
    if (grid == 0) {
        if (n_in != 22 || out_size != (int)O_END || ws_size < WS_NEED) { fprintf(stderr, "kernel_launch: unexpected shapes: n_in %d out %d ws %zu\n", n_in, out_size, ws_size); grid = -1; return; }
        int dev = 0, cus = 0, per_cu = 0;
        if (hipGetDevice(&dev) != hipSuccess || hipDeviceGetAttribute(&cus, hipDeviceAttributeMultiprocessorCount, dev) != hipSuccess) { grid = -1; return; }
        if (hipFuncSetAttribute((const void*)mk_fwd, hipFuncAttributeMaxDynamicSharedMemorySize, LDS_BYTES) != hipSuccess) { fprintf(stderr, "hipFuncSetAttribute failed\n"); grid = -1; return; }
        if (hipOccupancyMaxActiveBlocksPerMultiprocessor(&per_cu, (const void*)mk_fwd, NWAVES * 64, LDS_BYTES) != hipSuccess || per_cu < 1) { fprintf(stderr, "occupancy query: %d\n", per_cu); }
        (void)hipGetLastError();
        grid = cus;
        if (grid != 256) fprintf(stderr, "kernel_launch: %d CUs (built for 256)\n", grid);
    }
    if (grid < 0) return;
    Args a{};
    for (int i = 0; i < 22; ++i) a.in[i] = (const float*)d_in[i];
    a.out = (float*)d_out; a.ws = (unsigned char*)d_ws;
    void* args[] = {&a};
    hipError_t e = hipLaunchCooperativeKernel((const void*)mk_fwd, dim3(grid), dim3(NWAVES * 64), args, LDS_BYTES, stream);
    if (e != hipSuccess) fprintf(stderr, "cooperative launch failed: %s\n", hipGetErrorString(e));
}
```

```cpp
#include <hip/hip_runtime.h>
#include <hip/hip_cooperative_groups.h>
#include <cstdio>
#include <cstdint>
namespace cg = cooperative_groups;

#define LAS __attribute__((address_space(3)))
typedef unsigned short bf16_t;
typedef short bf16x8 __attribute__((ext_vector_type(8)));
typedef short s16x4 __attribute__((ext_vector_type(4)));
typedef float f32x4 __attribute__((ext_vector_type(4)));
typedef float f32x2 __attribute__((ext_vector_type(2)));
typedef float f32x16 __attribute__((ext_vector_type(16)));
typedef unsigned u32x4 __attribute__((ext_vector_type(4)));
typedef unsigned u32x2 __attribute__((ext_vector_type(2)));
typedef __bf16 bf16x2_t __attribute__((ext_vector_type(2)));

constexpr int DM = 2048, BATCH = 2, SEQ = 8192, DECB = 16, DECS = 32, PAST = 1024;
constexpr int MP = BATCH * SEQ, MS = DECB * DECS, MT = MP + MS;
constexpr int HA = 8, NOPE = 128, ROPE = 64, QKA = 192, VA = 128, QLORA = 512, KVLORA = 256;
constexpr int HB = 8, DHB = 128, BANDL = 512, MAXREL = 128, NREL = 257;
constexpr int INC = 3904, NCP = 4096;
constexpr int DFF = 8192;
constexpr int KVLEN = PAST + DECS;
constexpr int KVROWS = MP + DECB * KVLEN;
constexpr int BLEN = BANDL + DECS;
constexpr float EPS = 1e-6f;
constexpr float LOG2E = 1.4426950408889634f;
constexpr float QS_A = 0.07216878364870322f * LOG2E;
constexpr float QS_B = 0.08838834764831845f * LOG2E;

constexpr int CC_CQ = 0, CC_CKV = 512, CC_QB = 768, CC_KB = 1792, CC_VB = 2816, CC_KPE = 3840;

constexpr size_t O_Y = 0;
constexpr size_t O_CKVP = (size_t)MT * DM;
constexpr size_t O_KPEP = O_CKVP + (size_t)MP * KVLORA;
constexpr size_t O_BKP = O_KPEP + (size_t)MP * ROPE;
constexpr size_t O_BVP = O_BKP + (size_t)BATCH * BANDL * 1024;
constexpr size_t O_CKVS = O_BVP + (size_t)BATCH * BANDL * 1024;
constexpr size_t O_KPES = O_CKVS + (size_t)MS * KVLORA;
constexpr size_t O_BKS = O_KPES + (size_t)MS * ROPE;
constexpr size_t O_BVS = O_BKS + (size_t)MS * 1024;
constexpr size_t O_END = O_BVS + (size_t)MS * 1024;
static_assert(O_END == 43155456, "output size");

constexpr size_t MiB = 1u << 20;
constexpr size_t WS_ROPE = 1 * MiB;
constexpr int PU = DFF + 64;
constexpr size_t WS_WIN = 4 * MiB;
constexpr size_t WS_WUQ = 20 * MiB;
constexpr size_t WS_WUKV = 22 * MiB;
constexpr size_t WS_WO = 24 * MiB;
constexpr size_t WS_WUP = 32 * MiB;
constexpr size_t WS_WDN = 64 * MiB;
constexpr size_t WS_XN = 97 * MiB;
constexpr size_t WS_C = 163 * MiB;
constexpr size_t WS_QRAW = 163 * MiB;
constexpr size_t WS_KNRAW = 213 * MiB;
constexpr size_t WS_AO = 163 * MiB;
constexpr size_t WS_U = 163 * MiB;
constexpr size_t WS_QB = 295 * MiB;
constexpr size_t WS_KBP = 328 * MiB;
constexpr size_t WS_KBS = 360 * MiB;
constexpr size_t WS_VBP = 378 * MiB;
constexpr size_t WS_VBS = 410 * MiB;
constexpr size_t WS_CKV = 428 * MiB;
constexpr size_t WS_Q = 445 * MiB;
constexpr size_t WS_SSP = 4 * MiB;
constexpr size_t WS_AOS = 8 * MiB;
constexpr size_t WS_PCQ = 3 * MiB;
constexpr size_t WS_SLAB1 = 295 * MiB;
constexpr size_t WS_SLAB4 = 230 * MiB;
constexpr size_t WS_HB = 430 * MiB;
constexpr size_t WS_SLAB = 97 * MiB;
constexpr size_t WS_NEED = 497 * MiB;
static_assert(WS_U + (size_t)MT * PU * 2 <= WS_HB && WS_WDN + (size_t)DM * PU * 2 <= WS_XN, "map");
constexpr int CP = 640;
constexpr size_t OS_C2 = 0;
constexpr size_t OS_R = 21 * MiB;
constexpr size_t OS_SSPE = 30 * MiB;
constexpr size_t OS_K = 31 * MiB;

__device__ __forceinline__ unsigned cvtpk(float lo, float hi) { f32x2 v = {lo, hi}; bf16x2_t b = __builtin_convertvector(v, bf16x2_t); return __builtin_bit_cast(unsigned, b); }
__device__ __forceinline__ float bflo(unsigned w) { return __uint_as_float(w << 16); }
__device__ __forceinline__ float bfhi(unsigned w) { return __uint_as_float(w & 0xffff0000u); }
__device__ __forceinline__ void unpack8(u32x4 w, float* v) { v[0] = bflo(w.x); v[1] = bfhi(w.x); v[2] = bflo(w.y); v[3] = bfhi(w.y); v[4] = bflo(w.z); v[5] = bfhi(w.z); v[6] = bflo(w.w); v[7] = bfhi(w.w); }
__device__ __forceinline__ u32x4 pack8(const float* v) { u32x4 w; w.x = cvtpk(v[0], v[1]); w.y = cvtpk(v[2], v[3]); w.z = cvtpk(v[4], v[5]); w.w = cvtpk(v[6], v[7]); return w; }
__device__ __forceinline__ float red8(float v) { v += __shfl_xor(v, 1); v += __shfl_xor(v, 2); v += __shfl_xor(v, 4); return v; }
__device__ __forceinline__ float red16(float v) { v = red8(v); v += __shfl_xor(v, 8); return v; }
__device__ __forceinline__ float red64(float v) { v = red16(v); v += __shfl_xor(v, 16); v += __shfl_xor(v, 32); return v; }
#define LDS_WAIT() asm volatile("s_waitcnt lgkmcnt(0)" ::: "memory")
__device__ __forceinline__ void ld8f(const float* p, float* g) { const f32x4 a = *(const f32x4*)p, b = *(const f32x4*)(p + 4); g[0] = a[0]; g[1] = a[1]; g[2] = a[2]; g[3] = a[3]; g[4] = b[0]; g[5] = b[1]; g[6] = b[2]; g[7] = b[3]; }
__device__ __forceinline__ int lane_now() { int l; asm volatile("v_mbcnt_lo_u32_b32 %0, -1, 0\n\tv_mbcnt_hi_u32_b32 %0, -1, %0" : "=v"(l)); return l; }

namespace pg8 {
constexpr int BM = 256, BK = 64, HALF = 128, HTB = HALF * BK * 2, STAGE_BYTES = 8 * HTB, NXCD = 8, WGM = 8;
__host__ __device__ __forceinline__ int lds_byte(int r, int c) { const int st = (r >> 4) * 2 + (c >> 5), rr = r & 15, cc = c & 31, ob = rr * 64 + cc * 2; return st * 1024 + (ob ^ (((ob >> 9) & 1) << 5)); }
__host__ __device__ __forceinline__ void stage_rc(int b, int& R, int& C) { const int st = b / 1024, sb = b % 1024, swz = sb ^ (((sb >> 9) & 1) << 5); R = (st >> 1) * 16 + swz / 64; C = (st & 1) * 32 + (swz % 64) / 2; }
__host__ __device__ __forceinline__ int perm32(int rho) { const int n = rho >> 4, i = rho & 15; return 8 * (i >> 2) + 4 * n + (i & 3); }

struct Unit { int pm, pn; };
struct Gemm { const bf16_t* A; const bf16_t* Bt; int M, N, K, lda, ldb; };

struct StaticOrder {
    int nM, nN, nwg, G, c;
    __device__ void init(int M, int N, int G_, int c_) { nM = M / BM; nN = N / BM; nwg = nM * nN; G = G_; c = c_; }
    __device__ bool next(int i, Unit& u) const {
        const long L = (long)i * G + c; if (L >= nwg) return false;
        int wgid = (int)L; { const int q = nwg / NXCD, r = nwg % NXCD, xcd = wgid % NXCD, off = wgid / NXCD; wgid = (xcd < r ? xcd * (q + 1) : r * (q + 1) + (xcd - r) * q) + off; }
        const int nig = WGM * nN, gid = wgid / nig, fm = gid * WGM, gsz = (nM - fm) < WGM ? (nM - fm) : WGM;
        u.pm = fm + ((wgid % nig) % gsz); u.pn = (wgid % nig) / gsz; return true;
    }
};

template <int ACT  > struct EpiBf16 {
    static constexpr bool PERM = true;
    bf16_t* O; int ldc; int split_cols; long split_stride;
    __device__ __forceinline__ void operator()(const f32x4 (&acc)[2][2][4][2], const Unit& u, int wr, int wc, int fr, int fq) const {
        const int row0 = u.pm * BM + wr * 64 + fr; int colt = u.pn * BM; bf16_t* base = O;
        if (split_cols) { const int t = colt / split_cols; base += (long)t * split_stride; colt -= t * split_cols; }
        const int col0 = colt + wc * 32 + 8 * fq;
#pragma unroll
        for (int ai = 0; ai < 2; ++ai)
#pragma unroll
            for (int m = 0; m < 4; ++m) { bf16_t* rowp = base + (size_t)(row0 + ai * HALF + m * 16) * ldc + col0;
#pragma unroll
                for (int bj = 0; bj < 2; ++bj) { f32x4 v0 = acc[ai][bj][m][0], v1 = acc[ai][bj][m][1];
                    if (ACT == 1) {
#pragma unroll
                        for (int e = 0; e < 4; ++e) { float a, b; asm("v_max_f32 %0, 0, %1" : "=v"(a) : "v"(v0[e])); asm("v_max_f32 %0, 0, %1" : "=v"(b) : "v"(v1[e])); v0[e] = a * a; v1[e] = b * b; } }
                    u32x4 w; w.x = cvtpk(v0[0], v0[1]); w.y = cvtpk(v0[2], v0[3]); w.z = cvtpk(v1[0], v1[1]); w.w = cvtpk(v1[2], v1[3]);
                    *(u32x4*)(rowp + bj * HALF) = w; } }
    }
};
struct EpiQ {
    static constexpr bool PERM = true;
    bf16_t* Q; const float* PCQ; const float* g_qa; const float* ROPET; LAS unsigned char* lds;
    __device__ __forceinline__ void operator()(const f32x4 (&acc)[2][2][4][2], const Unit& u, int wr, int wc, int fr_, int fq_) const {
        int fr = fr_, fq = fq_; asm volatile("" : "+v"(fr), "+v"(fq));
        const int cl = wc * 32 + 8 * fq, h = u.pn;
        LAS float* P = (LAS float*)lds;
        LAS float* PQ = (LAS float*)(lds + 8192);
        const int tid_ = ((wr * 4 + wc) * 4 + fq) * 16 + fr;
        const f32x4 pq = *(const f32x4*)(PCQ + (size_t)(u.pm * BM + (tid_ >> 1)) * 8 + (tid_ & 1) * 4);
        float gn[8]; { const f32x4 ga = *(const f32x4*)(g_qa + cl), gb = *(const f32x4*)(g_qa + cl + 4);
            gn[0] = ga[0] * QS_A; gn[1] = ga[1] * QS_A; gn[2] = ga[2] * QS_A; gn[3] = ga[3] * QS_A; gn[4] = gb[0] * QS_A; gn[5] = gb[1] * QS_A; gn[6] = gb[2] * QS_A; gn[7] = gb[3] * QS_A; }
        const int ri = 16 * (wc & 1) + 4 * fq;
        float g1[4], g2[4]; { const f32x4 a = *(const f32x4*)(g_qa + NOPE + ri), b = *(const f32x4*)(g_qa + NOPE + 32 + ri);
#pragma unroll
            for (int e = 0; e < 4; ++e) { g1[e] = a[e] * QS_A; g2[e] = b[e] * QS_A; } }
#define ROPE_POS(i) ({ const int r_ = u.pm * BM + ((i) >> 2) * HALF + wr * 64 + ((i) & 3) * 16 + fr; r_ >= MP ? PAST + ((r_ - MP) & 31) : (r_ & (SEQ - 1)); })
        f32x4 cs[2], sn[2];
        if (wc < 2) {
#pragma unroll
            for (int k = 0; k < 2; ++k) { const int pos = ROPE_POS(k); cs[k] = *(const f32x4*)(ROPET + (size_t)pos * 64 + ri); sn[k] = *(const f32x4*)(ROPET + (size_t)pos * 64 + 32 + ri); } }
        { float ss[2][4][2];
#pragma unroll
          for (int ai = 0; ai < 2; ++ai)
#pragma unroll
            for (int m = 0; m < 4; ++m)
#pragma unroll
                for (int bj = 0; bj < 2; ++bj) { const f32x4 a = acc[ai][bj][m][0], b = acc[ai][bj][m][1];
                    float s = ((a[0] * a[0] + a[1] * a[1]) + (a[2] * a[2] + a[3] * a[3])) + ((b[0] * b[0] + b[1] * b[1]) + (b[2] * b[2] + b[3] * b[3]));
                    s += __shfl_xor(s, 16); s += __shfl_xor(s, 32); ss[ai][m][bj] = s; }
          if (fq == 0) {
#pragma unroll
            for (int ai = 0; ai < 2; ++ai)
#pragma unroll
                for (int m = 0; m < 4; ++m)
#pragma unroll
                    for (int bj = 0; bj < 2; ++bj) P[(ai * HALF + wr * 64 + m * 16 + fr) * 8 + bj * 4 + wc] = ss[ai][m][bj]; } }
        PQ[tid_] = (pq[0] + pq[1]) + (pq[2] + pq[3]);
        asm volatile("s_waitcnt lgkmcnt(0)\n\ts_barrier" ::: "memory");
#pragma unroll
        for (int g = 0; g < 4; ++g) {
            f32x4 cn[2], sm[2];
            if (wc < 2 && g < 3) {
#pragma unroll
                for (int k = 0; k < 2; ++k) { const int pos = ROPE_POS(2 * g + 2 + k); cn[k] = *(const f32x4*)(ROPET + (size_t)pos * 64 + ri); sm[k] = *(const f32x4*)(ROPET + (size_t)pos * 64 + 32 + ri); } }
#pragma unroll
            for (int k = 0; k < 2; ++k) { const int i = 2 * g + k, ai = i >> 2, m = i & 3; const int rl = ai * HALF + wr * 64 + m * 16 + fr; const int r = u.pm * BM + rl;
                const f32x4 pa = *(const LAS f32x4*)(P + rl * 8), pb = *(const LAS f32x4*)(P + rl * 8 + 4);
                const f32x2 pq2 = *(const LAS f32x2*)(PQ + rl * 2); const float rq = rsqrtf((pq2[0] + pq2[1]) * (1.f / 512.f) + EPS);
                const float ssr = ((pa[0] + pa[1]) + (pa[2] + pa[3])) + ((pb[0] + pb[1]) + (pb[2] + pb[3]));
                const float rstd = rq * rsqrtf(rq * rq * ssr * (1.f / 192.f) + EPS);
                bf16_t* qp = Q + (size_t)r * 1536 + h * QKA;
                { const f32x4 v0 = acc[ai][0][m][0] * rstd, v1 = acc[ai][0][m][1] * rstd;
                  u32x4 w; w.x = cvtpk(v0[0] * gn[0], v0[1] * gn[1]); w.y = cvtpk(v0[2] * gn[2], v0[3] * gn[3]); w.z = cvtpk(v1[0] * gn[4], v1[1] * gn[5]); w.w = cvtpk(v1[2] * gn[6], v1[3] * gn[7]);
                  *(u32x4*)(qp + cl) = w; }
                if (wc < 2) {
                  const f32x4 a0 = acc[ai][1][m][0] * rstd, a1 = acc[ai][1][m][1] * rstd; float o1[4], o2[4];
#pragma unroll
                  for (int e = 0; e < 4; ++e) { const float x1 = a0[e] * g1[e], x2 = a1[e] * g2[e]; o1[e] = x1 * cs[k][e] - x2 * sn[k][e]; o2[e] = x1 * sn[k][e] + x2 * cs[k][e]; }
                  u32x4 w; w.x = cvtpk(o1[0], o1[1]); w.y = cvtpk(o1[2], o1[3]); w.z = cvtpk(o2[0], o2[1]); w.w = cvtpk(o2[2], o2[3]);
                  *(u32x4*)(qp + NOPE + cl) = w; } }
            if (wc < 2 && g < 3) { cs[0] = cn[0]; cs[1] = cn[1]; sn[0] = sm[0]; sn[1] = sm[1]; }
        }
#undef ROPE_POS
    }
};
struct EpiKV {
    static constexpr bool PERM = true;
    unsigned char* os; unsigned char* ws; const float* g_ka; LAS unsigned char* lds;
    __device__ __forceinline__ void operator()(const f32x4 (&acc)[2][2][4][2], const Unit& u, int wr, int wc, int fr_, int fq_) const {
        int fr = fr_, fq = fq_; asm volatile("" : "+v"(fr), "+v"(fq));
        const int row0 = u.pm * BM + wr * 64 + fr, colt = u.pn * BM, cl = wc * 32 + 8 * fq;
        bf16_t* KM = (bf16_t*)(os + OS_K); bf16_t* VM = (bf16_t*)(ws + WS_XN); const float* R = (const float*)(os + OS_R); const float* SSPE = (const float*)(os + OS_SSPE);
        if (colt >= 1024) {
#pragma unroll
            for (int ai = 0; ai < 2; ++ai)
#pragma unroll
                for (int m = 0; m < 4; ++m) { bf16_t* rowp = VM + (size_t)(row0 + ai * HALF + m * 16) * 1024 + (colt - 1024) + cl;
#pragma unroll
                    for (int bj = 0; bj < 2; ++bj) { const f32x4 v0 = acc[ai][bj][m][0], v1 = acc[ai][bj][m][1];
                        u32x4 w; w.x = cvtpk(v0[0], v0[1]); w.y = cvtpk(v0[2], v0[3]); w.z = cvtpk(v1[0], v1[1]); w.w = cvtpk(v1[2], v1[3]);
                        *(u32x4*)(rowp + bj * HALF) = w; } }
        } else {
            LAS float* P = (LAS float*)lds;
            const int dsl = 16 * wc + 4 * fq;
            float sp[8]; f32x4 rv[4];
            float gg[8]; { const f32x4 ga = *(const f32x4*)(g_ka + cl), gb = *(const f32x4*)(g_ka + cl + 4); gg[0] = ga[0]; gg[1] = ga[1]; gg[2] = ga[2]; gg[3] = ga[3]; gg[4] = gb[0]; gg[5] = gb[1]; gg[6] = gb[2]; gg[7] = gb[3]; }
#pragma unroll
            for (int i = 0; i < 8; ++i) sp[i] = SSPE[u.pm * BM + (i >> 2) * HALF + wr * 64 + (i & 3) * 16 + fr];
#pragma unroll
            for (int m = 0; m < 4; ++m) rv[m] = *(const f32x4*)(R + (size_t)(u.pm * BM + wr * 64 + m * 16 + fr) * 64 + dsl);
            { float ss[2][4][2];
#pragma unroll
              for (int ai = 0; ai < 2; ++ai)
#pragma unroll
                for (int m = 0; m < 4; ++m)
#pragma unroll
                    for (int bj = 0; bj < 2; ++bj) { const f32x4 a = acc[ai][bj][m][0], b = acc[ai][bj][m][1];
                        float s = ((a[0] * a[0] + a[1] * a[1]) + (a[2] * a[2] + a[3] * a[3])) + ((b[0] * b[0] + b[1] * b[1]) + (b[2] * b[2] + b[3] * b[3]));
                        s += __shfl_xor(s, 16); s += __shfl_xor(s, 32); ss[ai][m][bj] = s; }
              if (fq == 0) {
#pragma unroll
                for (int ai = 0; ai < 2; ++ai)
#pragma unroll
                    for (int m = 0; m < 4; ++m)
#pragma unroll
                        for (int bj = 0; bj < 2; ++bj) P[(ai * HALF + wr * 64 + m * 16 + fr) * 8 + bj * 4 + wc] = ss[ai][m][bj]; } }
            asm volatile("s_waitcnt lgkmcnt(0)\n\ts_barrier" ::: "memory");
            const int h0 = (colt >> 7);
#pragma unroll
            for (int ai = 0; ai < 2; ++ai) {
                f32x4 rn[4];
                if (ai == 0) {
#pragma unroll
                    for (int m = 0; m < 4; ++m) rn[m] = *(const f32x4*)(R + (size_t)(u.pm * BM + HALF + wr * 64 + m * 16 + fr) * 64 + dsl); }
#pragma unroll
                for (int m = 0; m < 4; ++m) { const int rl = ai * HALF + wr * 64 + m * 16 + fr; const int r = u.pm * BM + rl;
#pragma unroll
                    for (int bj = 0; bj < 2; ++bj) { const f32x4 pp = *(const LAS f32x4*)(P + rl * 8 + bj * 4);
                        const float rstd = rsqrtf((((pp[0] + pp[1]) + (pp[2] + pp[3])) + sp[ai * 4 + m]) * (1.f / 192.f) + EPS);
                        u32x4 w; w.x = cvtpk(acc[ai][bj][m][0][0] * rstd * gg[0], acc[ai][bj][m][0][1] * rstd * gg[1]); w.y = cvtpk(acc[ai][bj][m][0][2] * rstd * gg[2], acc[ai][bj][m][0][3] * rstd * gg[3]);
                        w.z = cvtpk(acc[ai][bj][m][1][0] * rstd * gg[4], acc[ai][bj][m][1][1] * rstd * gg[5]); w.w = cvtpk(acc[ai][bj][m][1][2] * rstd * gg[6], acc[ai][bj][m][1][3] * rstd * gg[7]);
                        *(u32x4*)(KM + (size_t)r * 1536 + (h0 + bj) * QKA + cl) = w;
                        u32x2 wr2; wr2.x = cvtpk(rv[m][0] * rstd, rv[m][1] * rstd); wr2.y = cvtpk(rv[m][2] * rstd, rv[m][3] * rstd);
                        *(u32x2*)(KM + (size_t)r * 1536 + (h0 + bj) * QKA + NOPE + dsl) = wr2; } }
                if (ai == 0) {
#pragma unroll
                    for (int m = 0; m < 4; ++m) rv[m] = rn[m]; } }
        }
    }
};
struct EpiInproj {
    static constexpr bool PERM = true;
    bf16_t* C; bf16_t* QB; bf16_t* KBP; bf16_t* KBS; bf16_t* VBP; bf16_t* VBS; float* out; const float* g_qb; const float* g_kb; const float* g_ckv; bf16_t* CKV; float* PCQ; const float* g_ka; const float* ROPET; float* RR; float* SSPE; LAS unsigned char* lds;
    __device__ __forceinline__ void operator()(const f32x4 (&acc)[2][2][4][2], const Unit& u, int wr, int wc, int fr_, int fq_) const {
        int fr = fr_, fq = fq_; asm volatile("" : "+v"(fr), "+v"(fq));
        const int row0 = u.pm * BM + wr * 64 + fr, colt = u.pn * BM, cl = wc * 32 + 8 * fq;
        const bool samp = u.pm * BM >= MP; const bool fout = samp || ((u.pm & 31) >= 30);
        if (colt == CC_CKV) {
            LAS float* P = (LAS float*)lds;
            float gg[2][8];
#pragma unroll
            for (int bj = 0; bj < 2; ++bj) { const f32x4 ga = *(const f32x4*)(g_ckv + bj * HALF + cl), gb = *(const f32x4*)(g_ckv + bj * HALF + cl + 4);
                gg[bj][0] = ga[0]; gg[bj][1] = ga[1]; gg[bj][2] = ga[2]; gg[bj][3] = ga[3]; gg[bj][4] = gb[0]; gg[bj][5] = gb[1]; gg[bj][6] = gb[2]; gg[bj][7] = gb[3]; }
            { float ss[2][4][2];
#pragma unroll
              for (int ai = 0; ai < 2; ++ai)
#pragma unroll
                for (int m = 0; m < 4; ++m)
#pragma unroll
                    for (int bj = 0; bj < 2; ++bj) { const f32x4 a = acc[ai][bj][m][0], b = acc[ai][bj][m][1];
                        float s = ((a[0] * a[0] + a[1] * a[1]) + (a[2] * a[2] + a[3] * a[3])) + ((b[0] * b[0] + b[1] * b[1]) + (b[2] * b[2] + b[3] * b[3]));
                        s += __shfl_xor(s, 16); s += __shfl_xor(s, 32); ss[ai][m][bj] = s; }
              if (fq == 0) {
#pragma unroll
                for (int ai = 0; ai < 2; ++ai)
#pragma unroll
                    for (int m = 0; m < 4; ++m)
#pragma unroll
                        for (int bj = 0; bj < 2; ++bj) P[(ai * HALF + wr * 64 + m * 16 + fr) * 8 + bj * 4 + wc] = ss[ai][m][bj]; } }
            asm volatile("s_waitcnt lgkmcnt(0)\n\ts_barrier" ::: "memory");
#pragma unroll
            for (int ai = 0; ai < 2; ++ai)
#pragma unroll
                for (int m = 0; m < 4; ++m) { const int rl = ai * HALF + wr * 64 + m * 16 + fr, r = u.pm * BM + rl; const int sidx = r - MP;
                    const f32x4 pa = *(const LAS f32x4*)(P + rl * 8), pb = *(const LAS f32x4*)(P + rl * 8 + 4);
                    const float rstd = rsqrtf((((pa[0] + pa[1]) + (pa[2] + pa[3])) + ((pb[0] + pb[1]) + (pb[2] + pb[3]))) * (1.f / 256.f) + EPS);
                    float* fo = (samp ? out + O_CKVS + (size_t)sidx * KVLORA : out + O_CKVP + (size_t)r * KVLORA) + cl;
                    bf16_t* bo = CKV + (size_t)(samp ? MP + (sidx >> 5) * KVLEN + PAST + (sidx & 31) : r) * KVLORA + cl;
#pragma unroll
                    for (int bj = 0; bj < 2; ++bj) { f32x4 v0 = acc[ai][bj][m][0] * rstd, v1 = acc[ai][bj][m][1] * rstd;
#pragma unroll
                        for (int e = 0; e < 4; ++e) { v0[e] *= gg[bj][e]; v1[e] *= gg[bj][4 + e]; }
                        *(f32x4*)(fo + bj * HALF) = v0; *(f32x4*)(fo + bj * HALF + 4) = v1;
                        u32x4 w; w.x = cvtpk(v0[0], v0[1]); w.y = cvtpk(v0[2], v0[3]); w.z = cvtpk(v1[0], v1[1]); w.w = cvtpk(v1[2], v1[3]);
                        *(u32x4*)(bo + bj * HALF) = w; } }
        } else if (colt >= CC_KPE) {
            LAS float* P = (LAS float*)lds;
            { float ss[2][4];
#pragma unroll
              for (int ai = 0; ai < 2; ++ai)
#pragma unroll
                for (int m = 0; m < 4; ++m) { const f32x4 a = acc[ai][0][m][0], b = acc[ai][0][m][1];
                    float s = ((a[0] * a[0] + a[1] * a[1]) + (a[2] * a[2] + a[3] * a[3])) + ((b[0] * b[0] + b[1] * b[1]) + (b[2] * b[2] + b[3] * b[3]));
                    s += __shfl_xor(s, 16); s += __shfl_xor(s, 32); ss[ai][m] = s; }
              if (fq == 0 && wc < 2) {
#pragma unroll
                for (int ai = 0; ai < 2; ++ai)
#pragma unroll
                    for (int m = 0; m < 4; ++m) P[(ai * HALF + wr * 64 + m * 16 + fr) * 2 + wc] = ss[ai][m]; } }
            asm volatile("s_waitcnt lgkmcnt(0)\n\ts_barrier" ::: "memory");
            if (wc < 2) { const int ri = 16 * wc + 4 * fq;
                float g1[4], g2[4]; { const f32x4 a = *(const f32x4*)(g_ka + NOPE + ri), b = *(const f32x4*)(g_ka + NOPE + 32 + ri);
#pragma unroll
                    for (int e = 0; e < 4; ++e) { g1[e] = a[e]; g2[e] = b[e]; } }
#pragma unroll
                for (int ai = 0; ai < 2; ++ai) {
                    f32x4 csr[4], snr[4];
#pragma unroll
                    for (int m = 0; m < 4; ++m) { const int r = u.pm * BM + ai * HALF + wr * 64 + m * 16 + fr; const int pos = samp ? PAST + ((r - MP) & 31) : (r & (SEQ - 1));
                        csr[m] = *(const f32x4*)(ROPET + (size_t)pos * 64 + ri); snr[m] = *(const f32x4*)(ROPET + (size_t)pos * 64 + 32 + ri); }
#pragma unroll
                    for (int m = 0; m < 4; ++m) { const int rl = ai * HALF + wr * 64 + m * 16 + fr, r = u.pm * BM + rl; const int sidx = r - MP;
                        const size_t kvrow = samp ? (size_t)MP + (sidx >> 5) * KVLEN + PAST + (sidx & 31) : (size_t)r;
                        const f32x4 a0 = acc[ai][0][m][0], a1 = acc[ai][0][m][1];
                        float* fo = samp ? out + O_KPES + (size_t)sidx * ROPE : out + O_KPEP + (size_t)r * ROPE;
                        *(f32x4*)(fo + ri) = a0; *(f32x4*)(fo + 32 + ri) = a1;
                        const f32x4 cs = csr[m], sn = snr[m]; f32x4 o1, o2;
#pragma unroll
                        for (int e = 0; e < 4; ++e) { const float x1 = a0[e] * g1[e], x2 = a1[e] * g2[e]; o1[e] = x1 * cs[e] - x2 * sn[e]; o2[e] = x1 * sn[e] + x2 * cs[e]; }
                        *(f32x4*)(RR + kvrow * 64 + cl) = o1; *(f32x4*)(RR + kvrow * 64 + cl + 4) = o2;
                        if (fq == 0 && wc == 0) SSPE[kvrow] = P[rl * 2] + P[rl * 2 + 1]; }
                    asm volatile("" ::: "memory"); } }
        } else if (colt < CC_QB) {
            const bool iskpe = false; const int c2 = colt + cl;
#pragma unroll
            for (int ai = 0; ai < 2; ++ai)
#pragma unroll
                for (int m = 0; m < 4; ++m) { bf16_t* rowp = C + (size_t)(row0 + ai * HALF + m * 16) * CP + c2;
#pragma unroll
                    for (int bj = 0; bj < 2; ++bj) { const f32x4 v0 = acc[ai][bj][m][0], v1 = acc[ai][bj][m][1];
                        u32x4 w; w.x = cvtpk(v0[0], v0[1]); w.y = cvtpk(v0[2], v0[3]); w.z = cvtpk(v1[0], v1[1]); w.w = cvtpk(v1[2], v1[3]);
                        if (!iskpe) *(u32x4*)(rowp + bj * HALF) = w; else if (bj == 0 && wc < 2) *(u32x4*)rowp = w; }
                    if (!iskpe) { float s = 0.f;
#pragma unroll
                        for (int bj = 0; bj < 2; ++bj) { const f32x4 a = acc[ai][bj][m][0], b = acc[ai][bj][m][1]; s += ((a[0] * a[0] + a[1] * a[1]) + (a[2] * a[2] + a[3] * a[3])) + ((b[0] * b[0] + b[1] * b[1]) + (b[2] * b[2] + b[3] * b[3])); }
                        s += __shfl_xor(s, 16); s += __shfl_xor(s, 32);
                        if (fq == 0) PCQ[(size_t)(row0 + ai * HALF + m * 16) * 8 + u.pn * 4 + wc] = s; } }
        } else if (colt >= CC_VB) {
            const int lc0 = colt - CC_VB + cl;
#pragma unroll
            for (int ai = 0; ai < 2; ++ai)
#pragma unroll
                for (int m = 0; m < 4; ++m) { const int r = row0 + ai * HALF + m * 16; const int sidx = r - MP;
                    bf16_t* rowp = samp ? VBS + (size_t)((sidx >> 5) * BLEN + BANDL + (sidx & 31)) * 1024 + lc0 : VBP + (size_t)r * 1024 + lc0;
                    float* fo = samp ? out + O_BVS + (size_t)sidx * 1024 + lc0 : out + O_BVP + (size_t)((r >> 13) * BANDL + (r & (SEQ - 1)) - (SEQ - BANDL)) * 1024 + lc0;
#pragma unroll
                    for (int bj = 0; bj < 2; ++bj) { const f32x4 v0 = acc[ai][bj][m][0], v1 = acc[ai][bj][m][1];
                        u32x4 w; w.x = cvtpk(v0[0], v0[1]); w.y = cvtpk(v0[2], v0[3]); w.z = cvtpk(v1[0], v1[1]); w.w = cvtpk(v1[2], v1[3]);
                        *(u32x4*)(rowp + bj * HALF) = w;
                        if (fout) { *(f32x4*)(fo + bj * HALF) = v0; *(f32x4*)(fo + bj * HALF + 4) = v1; } } }
        } else {
            const bool isq = colt < CC_KB; const int lc0 = colt - (isq ? CC_QB : CC_KB) + cl;
            LAS float* P = (LAS float*)lds;
            float gg[8]; { const float* gp = (isq ? g_qb : g_kb) + (cl & 127); const f32x4 ga = *(const f32x4*)gp, gb = *(const f32x4*)(gp + 4);
                const float sc = isq ? QS_B : 1.f; gg[0] = ga[0] * sc; gg[1] = ga[1] * sc; gg[2] = ga[2] * sc; gg[3] = ga[3] * sc; gg[4] = gb[0] * sc; gg[5] = gb[1] * sc; gg[6] = gb[2] * sc; gg[7] = gb[3] * sc; }
            float ss[2][4][2];
#pragma unroll
            for (int ai = 0; ai < 2; ++ai)
#pragma unroll
                for (int m = 0; m < 4; ++m)
#pragma unroll
                    for (int bj = 0; bj < 2; ++bj) { const f32x4 a = acc[ai][bj][m][0], b = acc[ai][bj][m][1];
                        float s = ((a[0] * a[0] + a[1] * a[1]) + (a[2] * a[2] + a[3] * a[3])) + ((b[0] * b[0] + b[1] * b[1]) + (b[2] * b[2] + b[3] * b[3]));
                        s += __shfl_xor(s, 16); s += __shfl_xor(s, 32); ss[ai][m][bj] = s; }
            if (fq == 0) {
#pragma unroll
                for (int ai = 0; ai < 2; ++ai)
#pragma unroll
                    for (int m = 0; m < 4; ++m)
#pragma unroll
                        for (int bj = 0; bj < 2; ++bj) P[(ai * HALF + wr * 64 + m * 16 + fr) * 8 + bj * 4 + wc] = ss[ai][m][bj]; }
            asm volatile("s_waitcnt lgkmcnt(0)\n\ts_barrier" ::: "memory");
#pragma unroll
            for (int ai = 0; ai < 2; ++ai)
#pragma unroll
                for (int m = 0; m < 4; ++m) { const int rl = ai * HALF + wr * 64 + m * 16 + fr, r = u.pm * BM + rl; const int sidx = r - MP;
                    bf16_t* rowp = isq ? QB + (size_t)r * 1024 + lc0 : (samp ? KBS + (size_t)((sidx >> 5) * BLEN + BANDL + (sidx & 31)) * 1024 + lc0 : KBP + (size_t)r * 1024 + lc0);
                    float* fo = samp ? out + O_BKS + (size_t)sidx * 1024 + lc0 : out + O_BKP + (size_t)((r >> 13) * BANDL + (r & (SEQ - 1)) - (SEQ - BANDL)) * 1024 + lc0;
#pragma unroll
                    for (int bj = 0; bj < 2; ++bj) { const f32x4 pp = *(const LAS f32x4*)(P + rl * 8 + bj * 4);
                        const float rstd = rsqrtf(((pp[0] + pp[1]) + (pp[2] + pp[3])) * (1.f / 128.f) + EPS);
                        f32x4 v0 = acc[ai][bj][m][0] * rstd, v1 = acc[ai][bj][m][1] * rstd;
#pragma unroll
                        for (int e = 0; e < 4; ++e) { v0[e] *= gg[e]; v1[e] *= gg[4 + e]; }
                        u32x4 w; w.x = cvtpk(v0[0], v0[1]); w.y = cvtpk(v0[2], v0[3]); w.z = cvtpk(v1[0], v1[1]); w.w = cvtpk(v1[2], v1[3]);
                        *(u32x4*)(rowp + bj * HALF) = w;
                        if (!isq && fout) { *(f32x4*)(fo + bj * HALF) = v0; *(f32x4*)(fo + bj * HALF + 4) = v1; } } }
        }
    }
};
struct EpiResF32 {
    static constexpr bool PERM = false;
    const float* base; const float* base2; float* out;
    __device__ __forceinline__ void operator()(const f32x4 (&acc)[2][2][4][2], const Unit& u, int wr, int wc, int fr, int fq) const {
        const int rowt = u.pm * BM; const float* bp = base + (size_t)rowt * DM;
        if (base2 && rowt >= MP) bp = base2 + (size_t)(rowt - MP) * DM;
        const int col0 = u.pn * BM + wc * 32 + 4 * fq;
#pragma unroll
        for (int ai = 0; ai < 2; ++ai)
#pragma unroll
            for (int m = 0; m < 4; ++m) { const int r = ai * HALF + wr * 64 + m * 16 + fr; const size_t off = (size_t)r * DM + col0;
#pragma unroll
                for (int bj = 0; bj < 2; ++bj)
#pragma unroll
                    for (int n = 0; n < 2; ++n) { const f32x4 bs = *(const f32x4*)(bp + off + bj * HALF + n * 16); *(f32x4*)(out + (size_t)rowt * DM + off + bj * HALF + n * 16) = bs + acc[ai][bj][m][n]; }
                if (m & 1) asm volatile("" ::: "memory"); }
    }
};

struct EpiResBf16 {
    static constexpr bool PERM = true;
    const float* base0; const float* base2; bf16_t* out; float* PH;
    __device__ __forceinline__ void operator()(const f32x4 (&acc)[2][2][4][2], const Unit& u, int wr, int wc, int fr_, int fq_) const {
        int fr = fr_, fq = fq_; asm volatile("" : "+v"(fr), "+v"(fq));
        const int row0 = u.pm * BM + wr * 64 + fr, col0 = u.pn * BM + wc * 32 + 8 * fq;
        const float* base = (base2 && u.pm * BM >= MP) ? base2 - (size_t)MP * DM : base0;
#pragma unroll
        for (int ai = 0; ai < 2; ++ai) {
            f32x4 xr[4][2][2];
#pragma unroll
            for (int m = 0; m < 4; ++m) { const size_t off = (size_t)(row0 + ai * HALF + m * 16) * DM + col0;
#pragma unroll
                for (int bj = 0; bj < 2; ++bj) { xr[m][bj][0] = *(const f32x4*)(base + off + bj * HALF); xr[m][bj][1] = *(const f32x4*)(base + off + bj * HALF + 4); } }
#pragma unroll
            for (int m = 0; m < 4; ++m) { const size_t off = (size_t)(row0 + ai * HALF + m * 16) * DM + col0; float s = 0.f;
#pragma unroll
                for (int bj = 0; bj < 2; ++bj) {
                    const f32x4 v0 = acc[ai][bj][m][0] + xr[m][bj][0], v1 = acc[ai][bj][m][1] + xr[m][bj][1];
                    s += ((v0[0] * v0[0] + v0[1] * v0[1]) + (v0[2] * v0[2] + v0[3] * v0[3])) + ((v1[0] * v1[0] + v1[1] * v1[1]) + (v1[2] * v1[2] + v1[3] * v1[3]));
                    u32x4 w; w.x = cvtpk(v0[0], v0[1]); w.y = cvtpk(v0[2], v0[3]); w.z = cvtpk(v1[0], v1[1]); w.w = cvtpk(v1[2], v1[3]);
                    *(u32x4*)(out + off + bj * HALF) = w; }
                s += __shfl_xor(s, 16); s += __shfl_xor(s, 32);
                if (fq == 0) PH[(size_t)(row0 + ai * HALF + m * 16) * 32 + u.pn * 4 + wc] = s; }
            asm volatile("" ::: "memory"); }
    }
};
struct EpiAddBf16 {
    static constexpr bool PERM = false;
    const bf16_t* hb; float* out; const float* RS2;
    __device__ __forceinline__ void operator()(const f32x4 (&acc)[2][2][4][2], const Unit& u, int wr, int wc, int fr_, int fq_) const {
        int fr = fr_, fq = fq_; asm volatile("" : "+v"(fr), "+v"(fq));
        const int rowt = u.pm * BM, col0 = u.pn * BM + wc * 32 + 4 * fq;
#pragma unroll
        for (int ai = 0; ai < 2; ++ai) {
            u32x2 hw[4][2][2]; float rs2[4];
#pragma unroll
            for (int m = 0; m < 4; ++m) { const int r = rowt + ai * HALF + wr * 64 + m * 16 + fr; const size_t off = (size_t)r * DM + col0; rs2[m] = RS2[r];
#pragma unroll
                for (int bj = 0; bj < 2; ++bj)
#pragma unroll
                    for (int n = 0; n < 2; ++n) hw[m][bj][n] = *(const u32x2*)(hb + off + bj * HALF + n * 16); }
#pragma unroll
            for (int m = 0; m < 4; ++m) { const int r = rowt + ai * HALF + wr * 64 + m * 16 + fr; const size_t off = (size_t)r * DM + col0;
#pragma unroll
                for (int bj = 0; bj < 2; ++bj)
#pragma unroll
                    for (int n = 0; n < 2; ++n) { const u32x2 w = hw[m][bj][n];
                        const f32x4 h = {bflo(w.x), bfhi(w.x), bflo(w.y), bfhi(w.y)}; __builtin_nontemporal_store(h + acc[ai][bj][m][n] * rs2[m], (f32x4*)(out + off + bj * HALF + n * 16)); } }
            asm volatile("" ::: "memory"); }
    }
};
struct EpiSlab {
    static constexpr bool PERM = false;
    float* S; int nN;
    __device__ __forceinline__ void operator()(const f32x4 (&acc)[2][2][4][2], const Unit& u, int wr, int wc, int fr, int fq) const {
        float* tile = S + (nN ? (size_t)(u.pm * nN + u.pn) * 65536 : (size_t)0);
        const __amdgpu_buffer_rsrc_t rsrc = __builtin_amdgcn_make_buffer_rsrc((void*)tile, 0, 65536 * 4, 0x00020000);
        const unsigned c0 = (unsigned)(wc * 32 + 4 * fq) * 4u;
#pragma unroll
        for (int ai = 0; ai < 2; ++ai)
#pragma unroll
            for (int m = 0; m < 4; ++m) { const unsigned r = (unsigned)(ai * HALF + wr * 64 + m * 16 + fr);
#pragma unroll
                for (int bj = 0; bj < 2; ++bj)
#pragma unroll
                    for (int n = 0; n < 2; ++n) __builtin_amdgcn_raw_buffer_store_b128(__builtin_bit_cast(u32x4, acc[ai][bj][m][n]), rsrc, r * 1024u + c0 + (unsigned)(bj * HALF + n * 16) * 4u, 0,   16); }
    }
};
struct OneUnit { int pm, pn; bool on;
    __device__ bool next(int i, Unit& u) const { if (i > 0 || !on) return false; u.pm = pm; u.pn = pn; return true; } };

template <class Epi, class Sched>
__device__ __forceinline__ void gemm_phase(LAS unsigned char* lds, const Gemm g, const Sched& S, const Epi& E, const int wid) {
    const int lane = lane_now(), tid = wid * 64 + lane, wr = wid >> 2, wc = wid & 3, fr = lane & 15, fq = lane >> 4;
    const int K = g.K, nt = K / BK;
    unsigned voffA[2], voffB[2];
#pragma unroll
    for (int i = 0; i < 2; ++i) { int R, C; stage_rc(tid * 16 + i * 8192, R, C); const int Rb = Epi::PERM ? ((R & ~31) + perm32(R & 31)) : R;
        voffA[i] = (unsigned)(R * g.lda + C) * 2u; voffB[i] = (unsigned)(Rb * g.ldb + C) * 2u; }
    const size_t kstep = (size_t)(BK * 2);
    const size_t hstepA = (size_t)HALF * g.lda * 2, hstepB = (size_t)HALF * g.ldb * 2;
    const size_t tstepA = 2 * hstepA, tstepB = 2 * hstepB;
    const unsigned ldsw = (unsigned)wid * 1024u;
    const int aoff = lds_byte(wr * 64 + fr, fq * 8), boff = lds_byte(wc * 32 + fr, fq * 8);
#define PG8_SA(b, h) (((b) * 2 + (h)) * HTB)
#define PG8_SB(b, h) ((4 + (b) * 2 + (h)) * HTB)
#define PG8_STAGE(bufoff, gbase, voff) do { _Pragma("unroll") for (int _i = 0; _i < 2; ++_i) \
        __builtin_amdgcn_global_load_lds((const unsigned*)((const char*)(gbase) + (voff)[_i]), (LAS unsigned*)(lds + (bufoff) + ldsw + _i * 8192), 16, 0, 0); } while (0)
#define PG8_LDA(dst, b, h) do { _Pragma("unroll") for (int m = 0; m < 4; ++m) _Pragma("unroll") for (int k = 0; k < 2; ++k) dst[m][k] = *(const LAS bf16x8*)(lds + PG8_SA(b, h) + aoff + m * 2048 + k * 1024); } while (0)
#define PG8_LDB(dst, b, h) do { _Pragma("unroll") for (int n = 0; n < 2; ++n) _Pragma("unroll") for (int k = 0; k < 2; ++k) dst[n][k] = *(const LAS bf16x8*)(lds + PG8_SB(b, h) + boff + n * 2048 + k * 1024); } while (0)
#define PG8_MMA(ai, bj, At, Bt) do { __builtin_amdgcn_s_setprio(1); _Pragma("unroll") for (int m = 0; m < 4; ++m) _Pragma("unroll") for (int n = 0; n < 2; ++n) _Pragma("unroll") for (int k = 0; k < 2; ++k) \
        acc[ai][bj][m][n] = __builtin_amdgcn_mfma_f32_16x16x32_bf16(Bt[n][k], At[m][k], acc[ai][bj][m][n], 0, 0, 0); __builtin_amdgcn_s_setprio(0); } while (0)
#define PG8_WAIT_V(n) asm volatile("s_waitcnt vmcnt(" #n ")" ::: "memory")
#define PG8_WAIT_L(n) asm volatile("s_waitcnt lgkmcnt(" #n ")" ::: "memory")
#define PG8_BAR __builtin_amdgcn_s_barrier()
#define PG8_SCHED __builtin_amdgcn_sched_barrier(0)
    Unit cur, nxt; int ui = 0;
    if (!S.next(0, cur)) return;
    f32x4 acc[2][2][4][2];
#pragma unroll
    for (int a = 0; a < 2; ++a)
#pragma unroll
        for (int b = 0; b < 2; ++b)
#pragma unroll
            for (int m = 0; m < 4; ++m)
#pragma unroll
                for (int n = 0; n < 2; ++n) acc[a][b][m][n] = (f32x4){0.f, 0.f, 0.f, 0.f};
    bf16x8 At[4][2], B0[2][2], B1[2][2];
    const char* cA = (const char*)g.A + (size_t)cur.pm * tstepA; const char* cB = (const char*)g.Bt + (size_t)cur.pn * tstepB;
    PG8_STAGE(PG8_SB(0, 0), cB, voffB); PG8_STAGE(PG8_SB(0, 1), cB + hstepB, voffB); PG8_STAGE(PG8_SA(0, 0), cA, voffA); PG8_STAGE(PG8_SA(0, 1), cA + hstepA, voffA);
    if (wr == 1) PG8_BAR;
    PG8_WAIT_V(2); PG8_BAR;
    PG8_STAGE(PG8_SB(1, 0), cB + kstep, voffB); PG8_STAGE(PG8_SA(1, 0), cA + kstep, voffA); PG8_STAGE(PG8_SB(1, 1), cB + hstepB + kstep, voffB);
    PG8_WAIT_V(6); PG8_BAR;
    for (;;) {
        const bool has_next = S.next(ui + 1, nxt);
        const char* nA = has_next ? (const char*)g.A + (size_t)nxt.pm * tstepA : cA; const char* nB = has_next ? (const char*)g.Bt + (size_t)nxt.pn * tstepB : cB;
#pragma unroll 1
        for (int t = 0; t < nt; t += 2) {
            const bool last = (t == nt - 2);
            const char* a1 = cA + (size_t)(t + 1) * kstep;
            const char* a2 = last ? nA : cA + (size_t)(t + 2) * kstep; const char* b2 = last ? nB : cB + (size_t)(t + 2) * kstep;
            const char* a3 = a2 + kstep; const char* b3 = b2 + kstep;
            PG8_LDB(B0, 0, 0); PG8_LDB(B1, 0, 1); PG8_SCHED; PG8_LDA(At, 0, 0); PG8_STAGE(PG8_SA(1, 1), a1 + hstepA, voffA);
            PG8_WAIT_V(8); PG8_WAIT_L(0); PG8_BAR; PG8_MMA(0, 0, At, B0); PG8_MMA(0, 1, At, B1); PG8_BAR; PG8_SCHED;
            PG8_LDA(At, 0, 1); PG8_STAGE(PG8_SB(0, 0), b2, voffB); PG8_STAGE(PG8_SB(0, 1), b2 + hstepB, voffB); PG8_STAGE(PG8_SA(0, 0), a2, voffA);
            PG8_WAIT_V(8); PG8_WAIT_L(0); PG8_BAR; PG8_MMA(1, 0, At, B0); PG8_MMA(1, 1, At, B1); PG8_BAR; PG8_SCHED;
            PG8_LDB(B0, 1, 0); PG8_LDB(B1, 1, 1); PG8_SCHED; PG8_LDA(At, 1, 0); PG8_STAGE(PG8_SA(0, 1), a2 + hstepA, voffA);
            PG8_WAIT_V(8); PG8_WAIT_L(0); PG8_BAR; PG8_MMA(0, 0, At, B0); PG8_MMA(0, 1, At, B1); PG8_BAR; PG8_SCHED;
            PG8_LDA(At, 1, 1); PG8_STAGE(PG8_SB(1, 0), b3, voffB); PG8_STAGE(PG8_SB(1, 1), b3 + hstepB, voffB); PG8_STAGE(PG8_SA(1, 0), a3, voffA);
            PG8_WAIT_V(8); PG8_WAIT_L(0); PG8_BAR; PG8_MMA(1, 0, At, B0); PG8_MMA(1, 1, At, B1); PG8_BAR; PG8_SCHED;
        }
        if (wr == 0) PG8_BAR;
        E(acc, cur, wr, wc, fr, fq);
        if (!has_next) break;
#pragma unroll
        for (int a = 0; a < 2; ++a)
#pragma unroll
            for (int b = 0; b < 2; ++b)
#pragma unroll
                for (int m = 0; m < 4; ++m)
#pragma unroll
                    for (int n = 0; n < 2; ++n) acc[a][b][m][n] = (f32x4){0.f, 0.f, 0.f, 0.f};
        cur = nxt; cA = nA; cB = nB; ++ui;
        if (wr == 1) PG8_BAR;
    }
    PG8_WAIT_V(0);
    PG8_BAR;
#undef PG8_SA
#undef PG8_SB
#undef PG8_STAGE
#undef PG8_LDA
#undef PG8_LDB
#undef PG8_MMA
#undef PG8_WAIT_V
#undef PG8_WAIT_L
#undef PG8_BAR
#undef PG8_SCHED
}
}

namespace att {
constexpr int KSLOT = 24576, VSLOT = 16384, NSLOT = 3;
constexpr int L_K = 0, L_V = NSLOT * KSLOT, L_WS = L_V + NSLOT * VSLOT, L_BIAS = L_WS + 8 * 512, L_END = L_BIAS + 2048;
constexpr float THRL = 6.0f;
#define SBAR() __builtin_amdgcn_sched_barrier(0)
__device__ __forceinline__ int crow(int r, int hi) { return (r & 3) + 8 * (r >> 2) + 4 * hi; }
__device__ __forceinline__ void glds16(const void* sbase, unsigned voff, unsigned lds_dst) { unsigned keep;
    asm volatile("s_mov_b32 %0, m0\n\ts_mov_b32 m0, %3\n\ts_nop 4\n\tglobal_load_lds_dwordx4 %1, %2\n\ts_mov_b32 m0, %0" : "=&s"(keep) : "v"(voff), "s"(sbase), "s"(lds_dst) : "memory"); }
template <int OFF> __device__ __forceinline__ s16x4 tr_read(int vb) { s16x4 r; asm volatile("ds_read_b64_tr_b16 %0, %1 offset:%2" : "=&v"(r) : "v"(vb), "i"(OFF) : "memory"); return r; }
__device__ __forceinline__ int v_rd_base(int lane) { return ((lane & 3) << 3) | (((lane >> 2) & 3) << 6) | (((lane >> 4) & 1) << 5) | (((lane >> 5) & 1) << 8); }
constexpr int v_rd_off(int d0, int ks, int half) { return d0 * 512 + ks * 4096 + half * 2048; }
template <int D0> __device__ __forceinline__ void pv_one(f32x16& od, int vb, bf16x8 pa0, bf16x8 pa1, bf16x8 pa2, bf16x8 pa3) {
    const s16x4 l0 = tr_read<v_rd_off(D0, 0, 0)>(vb), h0 = tr_read<v_rd_off(D0, 0, 1)>(vb), l1 = tr_read<v_rd_off(D0, 1, 0)>(vb), h1 = tr_read<v_rd_off(D0, 1, 1)>(vb);
    const s16x4 l2 = tr_read<v_rd_off(D0, 2, 0)>(vb), h2 = tr_read<v_rd_off(D0, 2, 1)>(vb), l3 = tr_read<v_rd_off(D0, 3, 0)>(vb), h3 = tr_read<v_rd_off(D0, 3, 1)>(vb);
    asm volatile("s_waitcnt lgkmcnt(0)" ::: "memory"); SBAR();
#define PK(L, H) (bf16x8){L[0], L[1], L[2], L[3], H[0], H[1], H[2], H[3]}
    od = __builtin_amdgcn_mfma_f32_32x32x16_bf16(pa0, PK(l0, h0), od, 0, 0, 0);
    od = __builtin_amdgcn_mfma_f32_32x32x16_bf16(pa1, PK(l1, h1), od, 0, 0, 0);
    od = __builtin_amdgcn_mfma_f32_32x32x16_bf16(pa2, PK(l2, h2), od, 0, 0, 0);
    od = __builtin_amdgcn_mfma_f32_32x32x16_bf16(pa3, PK(l3, h3), od, 0, 0, 0);
#undef PK
}

struct UnitDesc {
    const bf16_t* Q; int ldq;
    const bf16_t* K; int ldk;
    const bf16_t* V; int ldv;
    bf16_t* O; int ldo;
    int t0, t1;
    int wlo, whi;
    int half_last;
    int rb0, rbstep, qi;
};

template <int DQK, bool BIAS>
__device__ __forceinline__ void attn_unit(const UnitDesc& u, LAS unsigned char* lds, const float* biasg  , const int wid) {
    constexpr int ND0 = DQK / 16;
    constexpr bool HASR = DQK > 128;
    constexpr int NDMA = HASR ? 5 : 4;
    const int lane = lane_now(), tid = wid * 64 + lane, r32 = lane & 31, hi = lane >> 5;
    const unsigned lds0 = (unsigned)(uintptr_t)lds;
    LAS float* wsf = (LAS float*)(lds + L_WS) + wid * 128;
    LAS float* bl = (LAS float*)(lds + L_BIAS);
    const bool active = u.wlo <= u.whi;
    unsigned koff[2], voff[2], roff = 0;
#pragma unroll
    for (int j = 0; j < 2; ++j) { const int i = 2 * wid + j;
        { const int row = 4 * i + (lane >> 4), c = (lane & 15) ^ (row & 7); koff[j] = (unsigned)(row * u.ldk + c * 8) * 2u; }
        { const int kk = (i >> 1) * 8 + ((lane & 31) >> 2), k = (kk & ~0xC) | ((kk & 4) << 1) | ((kk & 8) >> 1), col = (((2 * i + (lane >> 5)) & 3) << 5) + ((lane & 3) << 3); voff[j] = (unsigned)(k * u.ldv + col) * 2u; } }
    if (HASR) { const int row = 8 * wid + (lane >> 3), c = (lane & 7) ^ ((row >> 1) & 7); roff = (unsigned)(row * u.ldk + 128 + c * 8) * 2u; }
    const unsigned kdst = lds0 + L_K + (unsigned)wid * 2048u, rdst = lds0 + L_K + 16384u + (unsigned)wid * 1024u, vdst = lds0 + L_V + (unsigned)wid * 2048u;
#define UNI64(p) ((const void*)(((unsigned long long)(unsigned)__builtin_amdgcn_readfirstlane((int)((unsigned long long)(p) >> 32)) << 32) | (unsigned long long)(unsigned)__builtin_amdgcn_readfirstlane((int)(unsigned)(unsigned long long)(p))))
#define DMA_TILE(t, slot) do { const void* kb_ = UNI64(u.K + (size_t)(t) * 64 * u.ldk); const void* vb_ = UNI64(u.V + (size_t)(t) * 64 * u.ldv); \
        glds16(kb_, koff[0], (unsigned)__builtin_amdgcn_readfirstlane(kdst + (slot) * KSLOT)); glds16(kb_, koff[1], (unsigned)__builtin_amdgcn_readfirstlane(kdst + (slot) * KSLOT + 1024)); \
        if (HASR) glds16(kb_, roff, (unsigned)__builtin_amdgcn_readfirstlane(rdst + (slot) * KSLOT)); \
        glds16(vb_, voff[0], (unsigned)__builtin_amdgcn_readfirstlane(vdst + (slot) * VSLOT)); glds16(vb_, voff[1], (unsigned)__builtin_amdgcn_readfirstlane(vdst + (slot) * VSLOT + 1024)); } while (0)
    const int n = u.t1 - u.t0;
    bf16x8 qr[ND0];
    { const bf16_t* Qw = u.Q + (size_t)(wid * 32 + r32) * u.ldq + hi * 8;
#pragma unroll
      for (int d0 = 0; d0 < ND0; ++d0) qr[d0] = active ? *(const bf16x8*)(Qw + d0 * 16) : (bf16x8){0, 0, 0, 0, 0, 0, 0, 0}; }
    float bias_v = 0.f; if (BIAS && tid < NREL) bias_v = biasg[tid];
    DMA_TILE(u.t0, 0);
    if (n > 1) DMA_TILE(u.t0 + 1, 1);
    if (BIAS && tid < NREL) bl[tid] = bias_v * LOG2E;
    float m_reg = -1e30f, l_reg = 0.f; f32x16 o[4];
#pragma unroll
    for (int d = 0; d < 4; ++d) o[d] = f32x16{};
    const int vb0 = (int)(lds0 + L_V) + v_rd_base(lane);
    int slot = 0;
    __builtin_amdgcn_s_waitcnt(0x0F70);
    for (int j = 0; j < n; ++j) {
        const int t = u.t0 + j;
        if (j + 1 < n) { if (HASR) asm volatile("s_waitcnt vmcnt(5) lgkmcnt(0)\n\ts_barrier" ::: "memory"); else asm volatile("s_waitcnt vmcnt(4) lgkmcnt(0)\n\ts_barrier" ::: "memory"); }
        else asm volatile("s_waitcnt vmcnt(0) lgkmcnt(0)\n\ts_barrier" ::: "memory");
        if (j + 2 < n) { const int s2 = slot == 0 ? 2 : slot - 1; DMA_TILE(t + 2, s2); }
        if (t >= u.wlo && t <= u.whi) {
            const LAS unsigned char* Kb = lds + L_K + slot * KSLOT;
            const bool halfm = u.half_last && (t == u.t1 - 1);
            f32x16 p0, p1;
#pragma unroll
            for (int r = 0; r < 16; ++r) { p0[r] = -16.f; p1[r] = -16.f; }
#pragma unroll
            for (int d0 = 0; d0 < 8; ++d0) { const int ch = d0 * 2 + hi;
                const bf16x8 b0 = *(const LAS bf16x8*)(Kb + r32 * 256 + ((ch ^ (r32 & 7)) << 4));
                const bf16x8 b1 = *(const LAS bf16x8*)(Kb + (32 + r32) * 256 + ((ch ^ (r32 & 7)) << 4));
                p0 = __builtin_amdgcn_mfma_f32_32x32x16_bf16(b0, qr[d0], p0, 0, 0, 0);
                p1 = __builtin_amdgcn_mfma_f32_32x32x16_bf16(b1, qr[d0], p1, 0, 0, 0); }
            if (HASR) {
#pragma unroll
                for (int d0 = 8; d0 < ND0; ++d0) { const int ch = (d0 - 8) * 2 + hi;
                    const bf16x8 b0 = *(const LAS bf16x8*)(Kb + 16384 + r32 * 128 + ((ch ^ ((r32 >> 1) & 7)) << 4));
                    const bf16x8 b1 = *(const LAS bf16x8*)(Kb + 16384 + (32 + r32) * 128 + ((ch ^ (((32 + r32) >> 1) & 7)) << 4));
                    p0 = __builtin_amdgcn_mfma_f32_32x32x16_bf16(b0, qr[d0], p0, 0, 0, 0);
                    p1 = __builtin_amdgcn_mfma_f32_32x32x16_bf16(b1, qr[d0], p1, 0, 0, 0); } }
            __builtin_amdgcn_sched_group_barrier(0x100, 4, 0);
#pragma unroll
            for (int i_ = 0; i_ < 2 * ND0 - 4; ++i_) { __builtin_amdgcn_sched_group_barrier(0x8, 1, 0); __builtin_amdgcn_sched_group_barrier(0x100, 1, 0); }
            __builtin_amdgcn_sched_group_barrier(0x8, 4, 0);
            if (BIAS) {
                const int rbu = u.rb0 + u.rbstep * t, rb = rbu + u.qi;
                if (rbu - 63 >= MAXREL) { const float bc = bl[2 * MAXREL];
#pragma unroll
                    for (int r = 0; r < 16; ++r) { p0[r] += bc; p1[r] += bc; } }
                else {
#pragma unroll
                    for (int r = 0; r < 16; ++r) { const int k0 = crow(r, hi); int i0 = rb - k0, i1 = rb - k0 - 32;
                        i0 = min(max(i0, -MAXREL), MAXREL) + MAXREL; i1 = min(max(i1, -MAXREL), MAXREL) + MAXREL;
                        p0[r] += bl[i0]; p1[r] += bl[i1]; } }
            }
            if (halfm) {
#pragma unroll
                for (int r = 0; r < 16; ++r) p1[r] = -INFINITY; }
            float ps = 0.f;
#pragma unroll
            for (int r = 0; r < 16; ++r) { p0[r] = __builtin_amdgcn_exp2f(p0[r]); ps += p0[r]; }
#pragma unroll
            for (int r = 0; r < 16; ++r) { p1[r] = __builtin_amdgcn_exp2f(p1[r]); ps += p1[r]; }
            l_reg += ps;
            bf16x8 pa0, pa1, pa2, pa3;
#define PK4(P, BASE, OUT) do { unsigned a0 = cvtpk(P[BASE + 0], P[BASE + 1]), a1 = cvtpk(P[BASE + 2], P[BASE + 3]); \
    unsigned b0_ = cvtpk(P[BASE + 4], P[BASE + 5]), b1_ = cvtpk(P[BASE + 6], P[BASE + 7]); \
    auto r0 = __builtin_amdgcn_permlane32_swap(a0, b0_, false, false); auto r1 = __builtin_amdgcn_permlane32_swap(a1, b1_, false, false); \
    u32x4 w = {r0[0], r1[0], r0[1], r1[1]}; OUT = __builtin_bit_cast(bf16x8, w); } while (0)
            PK4(p0, 0, pa0); PK4(p0, 8, pa1); PK4(p1, 0, pa2); PK4(p1, 8, pa3);
#undef PK4
            const int vb = vb0 + slot * VSLOT;
            pv_one<0>(o[0], vb, pa0, pa1, pa2, pa3); pv_one<1>(o[1], vb, pa0, pa1, pa2, pa3); pv_one<2>(o[2], vb, pa0, pa1, pa2, pa3); pv_one<3>(o[3], vb, pa0, pa1, pa2, pa3);
        }
        slot = slot == 2 ? 0 : slot + 1;
    }
    asm volatile("s_waitcnt lgkmcnt(0)\n\ts_barrier" ::: "memory");
    if (active) {
        { auto rr = __builtin_amdgcn_permlane32_swap(__float_as_uint(l_reg), __float_as_uint(l_reg), false, false); l_reg = __uint_as_float(rr[0]) + __uint_as_float(rr[1]); }
        if (hi == 0) wsf[32 + r32] = l_reg; LDS_WAIT();
        LAS bf16_t* st = (LAS bf16_t*)(lds + wid * 8192);
#pragma unroll
        for (int r = 0; r < 16; ++r) { const int orow = crow(r, hi); const float rl = __builtin_amdgcn_rcpf(wsf[32 + orow]);
#pragma unroll
            for (int d0 = 0; d0 < 4; ++d0) { const unsigned w = cvtpk(o[d0][r] * rl, 0.f); st[orow * 128 + d0 * 32 + r32] = (bf16_t)(w & 0xffffu); } }
        LDS_WAIT();
        bf16_t* Ow = u.O + (size_t)(wid * 32) * u.ldo;
#pragma unroll
        for (int i = 0; i < 8; ++i) { const int row = i * 4 + (lane >> 4), ch = lane & 15; const u32x4 v = *(const LAS u32x4*)(st + row * 128 + ch * 8); *(u32x4*)(Ow + (size_t)row * u.ldo + ch * 8) = v; }
    }
    asm volatile("s_waitcnt lgkmcnt(0)\n\ts_barrier" ::: "memory");
#undef DMA_TILE
}

template <int DQK, bool BIAS>
__device__ __forceinline__ void attn_unit_ks(const UnitDesc& u, LAS unsigned char* lds, const float* biasg, const int wid) {
    constexpr int ND0 = DQK / 16;
    constexpr bool HASR = DQK > 128;
    constexpr int NDMA = HASR ? 5 : 4;
    const int lane = lane_now(), tid = wid * 64 + lane, r32 = lane & 31, hi = lane >> 5;
    const unsigned lds0 = (unsigned)(uintptr_t)lds;
    LAS float* wsf = (LAS float*)(lds + L_WS) + wid * 128;
    LAS float* bl = (LAS float*)(lds + L_BIAS);
    const bool active = wid < 2;
    unsigned koff[2], voff[2], roff = 0;
#pragma unroll
    for (int j = 0; j < 2; ++j) { const int i = 2 * wid + j;
        { const int row = 4 * i + (lane >> 4), c = (lane & 15) ^ (row & 7); koff[j] = (unsigned)(row * u.ldk + c * 8) * 2u; }
        { const int kk = (i >> 1) * 8 + ((lane & 31) >> 2), k = (kk & ~0xC) | ((kk & 4) << 1) | ((kk & 8) >> 1), col = (((2 * i + (lane >> 5)) & 3) << 5) + ((lane & 3) << 3); voff[j] = (unsigned)(k * u.ldv + col) * 2u; } }
    if (HASR) { const int row = 8 * wid + (lane >> 3), c = (lane & 7) ^ ((row >> 1) & 7); roff = (unsigned)(row * u.ldk + 128 + c * 8) * 2u; }
    const unsigned kdst = lds0 + L_K + (unsigned)wid * 2048u, rdst = lds0 + L_K + 16384u + (unsigned)wid * 1024u, vdst = lds0 + L_V + (unsigned)wid * 2048u;
#define DMA_TILE(t, slot) do { const void* kb_ = UNI64(u.K + (size_t)(t) * 64 * u.ldk); const void* vb_ = UNI64(u.V + (size_t)(t) * 64 * u.ldv); \
        glds16(kb_, koff[0], (unsigned)__builtin_amdgcn_readfirstlane(kdst + (slot) * KSLOT)); glds16(kb_, koff[1], (unsigned)__builtin_amdgcn_readfirstlane(kdst + (slot) * KSLOT + 1024)); \
        if (HASR) glds16(kb_, roff, (unsigned)__builtin_amdgcn_readfirstlane(rdst + (slot) * KSLOT)); \
        glds16(vb_, voff[0], (unsigned)__builtin_amdgcn_readfirstlane(vdst + (slot) * VSLOT)); glds16(vb_, voff[1], (unsigned)__builtin_amdgcn_readfirstlane(vdst + (slot) * VSLOT + 1024)); } while (0)
    const int n = u.t1 - u.t0;
    bf16x8 qr[ND0];
    { const bf16_t* Qw = u.Q + (size_t)r32 * u.ldq + hi * 8;
#pragma unroll
      for (int d0 = 0; d0 < ND0; ++d0) qr[d0] = active ? *(const bf16x8*)(Qw + d0 * 16) : (bf16x8){0, 0, 0, 0, 0, 0, 0, 0}; }
    float bias_v = 0.f; if (BIAS && tid < NREL) bias_v = biasg[tid];
    DMA_TILE(u.t0, 0);
    if (n > 1) DMA_TILE(u.t0 + 1, 1);
    if (BIAS && tid < NREL) bl[tid] = bias_v * LOG2E;
    float l_reg = 0.f; f32x16 o[4];
#pragma unroll
    for (int d = 0; d < 4; ++d) o[d] = f32x16{};
    const int krow = wid * 32 + r32;
    const int vb0 = (int)(lds0 + L_V) + v_rd_base(lane) + wid * 8192;
    const int wlast = wid == 0 ? u.t1 - 1 : u.t1 - 2;
    int slot = 0;
    __builtin_amdgcn_s_waitcnt(0x0F70);
    for (int j = 0; j < n; ++j) {
        const int t = u.t0 + j;
        if (j + 1 < n) { if (HASR) asm volatile("s_waitcnt vmcnt(5) lgkmcnt(0)\n\ts_barrier" ::: "memory"); else asm volatile("s_waitcnt vmcnt(4) lgkmcnt(0)\n\ts_barrier" ::: "memory"); }
        else asm volatile("s_waitcnt vmcnt(0) lgkmcnt(0)\n\ts_barrier" ::: "memory");
        if (j + 2 < n) { const int s2 = slot == 0 ? 2 : slot - 1; DMA_TILE(t + 2, s2); }
        if (active && t <= wlast) {
            const LAS unsigned char* Kb = lds + L_K + slot * KSLOT;
            f32x16 pk;
#pragma unroll
            for (int r = 0; r < 16; ++r) pk[r] = -16.f;
#pragma unroll
            for (int d0 = 0; d0 < 8; ++d0) { const int ch = d0 * 2 + hi;
                const bf16x8 b = *(const LAS bf16x8*)(Kb + krow * 256 + ((ch ^ (r32 & 7)) << 4));
                pk = __builtin_amdgcn_mfma_f32_32x32x16_bf16(b, qr[d0], pk, 0, 0, 0); }
            if (HASR) {
#pragma unroll
                for (int d0 = 8; d0 < ND0; ++d0) { const int ch = (d0 - 8) * 2 + hi;
                    const bf16x8 b = *(const LAS bf16x8*)(Kb + 16384 + krow * 128 + ((ch ^ ((r32 >> 1) & 7)) << 4));
                    pk = __builtin_amdgcn_mfma_f32_32x32x16_bf16(b, qr[d0], pk, 0, 0, 0); } }
            if (BIAS) {
                const int rb = u.rb0 + u.rbstep * t + u.qi - 32 * wid;
#pragma unroll
                for (int r = 0; r < 16; ++r) { int i0 = rb - crow(r, hi); i0 = min(max(i0, -MAXREL), MAXREL) + MAXREL; pk[r] += bl[i0]; }
            }
            float ps = 0.f;
#pragma unroll
            for (int r = 0; r < 16; ++r) { pk[r] = __builtin_amdgcn_exp2f(pk[r]); ps += pk[r]; }
            l_reg += ps;
            bf16x8 pa0, pa1;
#define PK4(P, BASE, OUT) do { unsigned a0 = cvtpk(P[BASE + 0], P[BASE + 1]), a1 = cvtpk(P[BASE + 2], P[BASE + 3]); \
    unsigned b0_ = cvtpk(P[BASE + 4], P[BASE + 5]), b1_ = cvtpk(P[BASE + 6], P[BASE + 7]); \
    auto r0 = __builtin_amdgcn_permlane32_swap(a0, b0_, false, false); auto r1 = __builtin_amdgcn_permlane32_swap(a1, b1_, false, false); \
    u32x4 w = {r0[0], r1[0], r0[1], r1[1]}; OUT = __builtin_bit_cast(bf16x8, w); } while (0)
            PK4(pk, 0, pa0); PK4(pk, 8, pa1);
#undef PK4
            const int vb = vb0 + slot * VSLOT;
#define PV2(D0) do { const s16x4 l0 = tr_read<v_rd_off(D0, 0, 0)>(vb), h0 = tr_read<v_rd_off(D0, 0, 1)>(vb), l1 = tr_read<v_rd_off(D0, 1, 0)>(vb), h1 = tr_read<v_rd_off(D0, 1, 1)>(vb); \
        asm volatile("s_waitcnt lgkmcnt(0)" ::: "memory"); SBAR(); \
        o[D0] = __builtin_amdgcn_mfma_f32_32x32x16_bf16(pa0, ((bf16x8){l0[0], l0[1], l0[2], l0[3], h0[0], h0[1], h0[2], h0[3]}), o[D0], 0, 0, 0); \
        o[D0] = __builtin_amdgcn_mfma_f32_32x32x16_bf16(pa1, ((bf16x8){l1[0], l1[1], l1[2], l1[3], h1[0], h1[1], h1[2], h1[3]}), o[D0], 0, 0, 0); } while (0)
            PV2(0); PV2(1); PV2(2); PV2(3);
#undef PV2
        }
        slot = slot == 2 ? 0 : slot + 1;
    }
    asm volatile("s_waitcnt lgkmcnt(0)\n\ts_barrier" ::: "memory");
    LAS float* xo = (LAS float*)(lds + 16384);
    if (wid == 1) {
#pragma unroll
        for (int d0 = 0; d0 < 4; ++d0)
#pragma unroll
            for (int r = 0; r < 16; ++r) xo[(d0 * 16 + r) * 64 + lane] = o[d0][r];
        wsf[lane] = l_reg;
    }
    asm volatile("s_waitcnt lgkmcnt(0)\n\ts_barrier" ::: "memory");
    if (wid == 0) {
#pragma unroll
        for (int d0 = 0; d0 < 4; ++d0)
#pragma unroll
            for (int r = 0; r < 16; ++r) o[d0][r] += xo[(d0 * 16 + r) * 64 + lane];
        l_reg += ((LAS float*)(lds + L_WS) + 128)[lane];
        { auto rr = __builtin_amdgcn_permlane32_swap(__float_as_uint(l_reg), __float_as_uint(l_reg), false, false); l_reg = __uint_as_float(rr[0]) + __uint_as_float(rr[1]); }
        if (hi == 0) wsf[32 + r32] = l_reg; LDS_WAIT();
        LAS bf16_t* st = (LAS bf16_t*)(lds);
#pragma unroll
        for (int r = 0; r < 16; ++r) { const int orow = crow(r, hi); const float rl = __builtin_amdgcn_rcpf(wsf[32 + orow]);
#pragma unroll
            for (int d0 = 0; d0 < 4; ++d0) { const unsigned w = cvtpk(o[d0][r] * rl, 0.f); st[orow * 128 + d0 * 32 + r32] = (bf16_t)(w & 0xffffu); } }
        LDS_WAIT();
        bf16_t* Ow = u.O;
#pragma unroll
        for (int i = 0; i < 8; ++i) { const int row = i * 4 + (lane >> 4), ch = lane & 15; const u32x4 v = *(const LAS u32x4*)(st + row * 128 + ch * 8); *(u32x4*)(Ow + (size_t)row * u.ldo + ch * 8) = v; }
    }
    asm volatile("s_waitcnt lgkmcnt(0)\n\ts_barrier" ::: "memory");
#undef DMA_TILE
}
#undef SBAR
}

struct Args { const float* in[22]; float* out; unsigned char* ws; };
constexpr int LDS_BYTES = 147456;
constexpr int NWAVES = 8;
#ifndef PH
#define PH 1023
#endif
#ifndef SPLIT_IN
#define SPLIT_IN 0
#endif
#ifndef SPLIT_WO
#define SPLIT_WO 0
#endif
#ifndef SPLIT_UP
#define SPLIT_UP 0
#endif
#ifndef DBL
#define DBL 0
#endif
#define REP(bit) for (int rep_ = 0; rep_ < (((DBL) & (bit)) ? 2 : 1); ++rep_)
#ifndef SYNCS
#define SYNCS 1
#endif
#define GSYNC() do { for (int s_ = 0; s_ < SYNCS; ++s_) { unsigned* bw_ = (unsigned*)(KWS(kargs()) + WS_BAR); xcd_barrier(bw_, xcc, xst, wave, lane_now()); } } while (0)

__device__ __forceinline__ void transpose_item(const float* W, int ldw, int col0, bf16_t* WT, int ldt, int row0, int k0, LAS float* scr, int lane, const float* gk = nullptr, int ropeblk = -1) {
    if (col0 >= 0) {
        const int l = lane & 31, cofs = ropeblk < 0 ? l : 32 * ((l >> 2) & 1) + 16 * ropeblk + 4 * (l >> 3) + (l & 3);
#pragma unroll 8
        for (int i = 0; i < 32; ++i) { const int kk = 2 * i + (lane >> 5); float w = W[(size_t)(k0 + kk) * ldw + col0 + cofs]; if (gk) w *= gk[k0 + kk]; scr[kk * 33 + (lane & 31)] = w; }
    } else {
#pragma unroll 8
        for (int i = 0; i < 32; ++i) { const int kk = 2 * i + (lane >> 5); scr[kk * 33 + (lane & 31)] = 0.f; }
    }
    LDS_WAIT(); asm volatile("" ::: "memory");
    const int c = lane & 7;
#pragma unroll
    for (int j = 0; j < 4; ++j) { const int n = (lane >> 3) + 8 * j; const LAS float* s = scr + (8 * c) * 33 + n;
        u32x4 o; o.x = cvtpk(s[0 * 33], s[1 * 33]); o.y = cvtpk(s[2 * 33], s[3 * 33]); o.z = cvtpk(s[4 * 33], s[5 * 33]); o.w = cvtpk(s[6 * 33], s[7 * 33]);
        *(u32x4*)(WT + (size_t)(row0 + n) * ldt + k0 + 8 * c) = o; }
    LDS_WAIT(); asm volatile("" ::: "memory");
}
__device__ __forceinline__ void transpose_wide(const float* W, int ldw, int n0, bf16_t* WT, int ldt, int k0, LAS unsigned char* scr, int lane, const float* gk = nullptr) {
    const float* src = W + (size_t)k0 * ldw + n0 + lane;
    const unsigned wbase = (unsigned)lane * 256u, wx = (unsigned)(lane & 15);
#pragma unroll 1
    for (int rb = 0; rb < 128; rb += 16) {
        float v[16];
#pragma unroll
        for (int i = 0; i < 16; ++i) v[i] = src[(size_t)(rb + i) * ldw];
        if (gk) {
#pragma unroll
            for (int i = 0; i < 16; ++i) v[i] *= gk[k0 + rb + i]; }
#pragma unroll
        for (int i = 0; i < 16; i += 2) { const int r = rb + i;
            *(LAS unsigned*)(scr + wbase + ((((unsigned)(r >> 3)) ^ wx) << 4) + (((unsigned)(r >> 1)) & 3u) * 4u) = cvtpk(v[i], v[i + 1]); }
    }
    LDS_WAIT(); asm volatile("" ::: "memory");
#pragma unroll
    for (int j = 0; j < 16; ++j) { const int row = 4 * j + (lane >> 4), ch = lane & 15;
        const u32x4 o = *(const LAS u32x4*)(scr + row * 256 + ((ch ^ (row & 15)) << 4));
        *(u32x4*)(WT + (size_t)(n0 + row) * ldt + k0 + 8 * ch) = o; }
    LDS_WAIT(); asm volatile("" ::: "memory");
}
__device__ __forceinline__ void rms_row_2048(const float* xrow, const float* g, bf16_t* orow, int lane) {
    f32x4 v[8]; float s = 0.f;
#pragma unroll
    for (int j = 0; j < 8; ++j) { v[j] = *((const f32x4*)xrow + lane + 64 * j); s += (v[j].x * v[j].x + v[j].y * v[j].y) + (v[j].z * v[j].z + v[j].w * v[j].w); }
    const float rstd = rsqrtf(red64(s) * (1.f / 2048.f) + EPS);
#pragma unroll
    for (int j = 0; j < 8; ++j) { const f32x4 gg = *((const f32x4*)g + lane + 64 * j); u32x2 w; w.x = cvtpk(v[j].x * rstd * gg.x, v[j].y * rstd * gg.y); w.y = cvtpk(v[j].z * rstd * gg.z, v[j].w * rstd * gg.w);
        *((u32x2*)orow + lane + 64 * j) = w; }
}
template <class RowPtr>
__device__ __forceinline__ void rms_pass_2048(const RowPtr& rowptr, int nrows, const float* g, bf16_t* out, int gw, int NGW, int lane) {
    f32x4 nx[8], ny[8], gv[8];
#pragma unroll
    for (int j = 0; j < 8; ++j) gv[j] = *((const f32x4*)g + lane + 64 * j);
    if (gw < nrows) {
#pragma unroll
        for (int j = 0; j < 8; ++j) nx[j] = __builtin_nontemporal_load((const f32x4*)rowptr(gw) + lane + 64 * j); }
    if (gw + NGW < nrows) {
#pragma unroll
        for (int j = 0; j < 8; ++j) ny[j] = __builtin_nontemporal_load((const f32x4*)rowptr(gw + NGW) + lane + 64 * j); }
#define RMS_ROW(BUF, M) do { f32x4 v[8]; float s = 0.f; \
        _Pragma("unroll") for (int j = 0; j < 8; ++j) { v[j] = BUF[j]; s += (v[j].x * v[j].x + v[j].y * v[j].y) + (v[j].z * v[j].z + v[j].w * v[j].w); } \
        if ((M) + 2 * NGW < nrows) { _Pragma("unroll") for (int j = 0; j < 8; ++j) BUF[j] = __builtin_nontemporal_load((const f32x4*)rowptr((M) + 2 * NGW) + lane + 64 * j); } \
        const float rstd = rsqrtf(red64(s) * (1.f / 2048.f) + EPS); bf16_t* orow = out + (size_t)(M) * DM; \
        _Pragma("unroll") for (int j = 0; j < 8; ++j) { const f32x4 gg = gv[j]; u32x2 w; w.x = cvtpk(v[j].x * rstd * gg.x, v[j].y * rstd * gg.y); w.y = cvtpk(v[j].z * rstd * gg.z, v[j].w * rstd * gg.w); \
            *((u32x2*)orow + lane + 64 * j) = w; } } while (0)
    for (int m = gw; m < nrows; m += 2 * NGW) {
        RMS_ROW(nx, m);
        if (m + NGW < nrows) RMS_ROW(ny, m + NGW);
    }
#undef RMS_ROW
}
__device__ __forceinline__ void rms_pass_bf16_2048(const bf16_t* in, int nrows, const float* g, bf16_t* out, int gw, int NGW, int lane) {
    u32x4 nx[4];
    if (gw < nrows) {
#pragma unroll
        for (int j = 0; j < 4; ++j) nx[j] = *((const u32x4*)(in + (size_t)gw * DM) + lane + 64 * j); }
    for (int m = gw; m < nrows; m += NGW) {
        float v[4][8]; float s = 0.f;
#pragma unroll
        for (int j = 0; j < 4; ++j) { unpack8(nx[j], v[j]);
#pragma unroll
            for (int e = 0; e < 8; ++e) s += v[j][e] * v[j][e]; }
        if (m + NGW < nrows) {
#pragma unroll
            for (int j = 0; j < 4; ++j) nx[j] = *((const u32x4*)(in + (size_t)(m + NGW) * DM) + lane + 64 * j); }
        const float rstd = rsqrtf(red64(s) * (1.f / 2048.f) + EPS);
#pragma unroll
        for (int j = 0; j < 4; ++j) { float gg[8]; ld8f(g + (lane + 64 * j) * 8, gg); float o[8];
#pragma unroll
            for (int e = 0; e < 8; ++e) o[e] = v[j][e] * rstd * gg[e];
            *((u32x4*)(out + (size_t)m * DM) + lane + 64 * j) = pack8(o); }
    }
}
struct RowPtrX { const float* xp; const float* xs; __device__ __forceinline__ const float* operator()(int m) const { return m < MP ? xp + (size_t)m * DM : xs + (size_t)(m - MP) * DM; } };
struct RowPtrY { const float* y; __device__ __forceinline__ const float* operator()(int m) const { return y + (size_t)m * DM; } };
__device__ __forceinline__ void kpe_item(const float* v, int c8, int kvrow, int pos, bool valid, const float* g_ka, const float* ropetab, float* R, float* SSPE) {
    float ss = 0.f;
#pragma unroll
    for (int e = 0; e < 8; ++e) ss += v[e] * v[e];
    ss = red8(ss);
    float x[8], px[8];
#pragma unroll
    for (int e = 0; e < 8; ++e) x[e] = v[e] * g_ka[NOPE + 8 * c8 + e];
#pragma unroll
    for (int e = 0; e < 8; ++e) px[e] = __shfl_xor(x[e], 4);
    const int i0 = 8 * (c8 & 3);
    if (valid) {
        const float* ct = ropetab + (size_t)pos * 64 + i0; float o[8];
#pragma unroll
        for (int e = 0; e < 8; ++e) { const float c = ct[e], s = ct[32 + e]; o[e] = (c8 < 4) ? (x[e] * c - px[e] * s) : (px[e] * s + x[e] * c); }
        const int p0 = 32 * ((c8 >> 1) & 1) + 16 * (c8 & 1) + 4 * (c8 >> 2);
        *(f32x4*)(R + (size_t)kvrow * 64 + p0) = (f32x4){o[0], o[1], o[2], o[3]}; *(f32x4*)(R + (size_t)kvrow * 64 + p0 + 8) = (f32x4){o[4], o[5], o[6], o[7]};
        if (c8 == 0) SSPE[kvrow] = ss;
    }
}


#define RLX_AGENT __ATOMIC_RELAXED, __HIP_MEMORY_SCOPE_AGENT
#define XB_TMO      128
#define XB_XCNT(j)  (256  + 64 * (j))
#define XB_XSUB(j)  (1280 + 64 * (j))
#define XB_XGEN(j)  (2304 + 64 * (j))
#define XB_TOP      3328
#define XB_TOPGEN   3392
#define XCD_BAR_WORDS 3456
#define XB_SPIN_CAP (1u << 20)
__device__ __forceinline__ unsigned xb_ld(unsigned* p)              { return __hip_atomic_load(p, __ATOMIC_RELAXED, __HIP_MEMORY_SCOPE_AGENT); }
__device__ __forceinline__ unsigned xb_add(unsigned* p, unsigned v) { return __hip_atomic_fetch_add(p, v, __ATOMIC_RELAXED, __HIP_MEMORY_SCOPE_AGENT); }
__device__ __forceinline__ unsigned xb_xcc_id() { return (unsigned)__builtin_amdgcn_s_getreg((3 << 11) | 20) & 0xFu; }
#define XB_SPIN(cond, bar) do { unsigned _sp = 0; while (cond) { __builtin_amdgcn_s_sleep(1); \
    if ((++_sp & 255u) == 0u) { if (xb_ld(&(bar)[XB_TMO])) break; if (_sp > XB_SPIN_CAP) { atomicAdd(&(bar)[XB_TMO], 1u); break; } } } } while (0)
__device__ __forceinline__ void xcd_barrier_complete(unsigned* bar, unsigned x, unsigned& nloc, unsigned& nx) {
    const unsigned G = gridDim.x * gridDim.y * gridDim.z;
    unsigned sum, cnt, mine, sp = 0u;
    for (;;) {
        sum = 0u; cnt = 0u; mine = 0u;
#pragma unroll
        for (unsigned j = 0; j < 16; ++j) { const unsigned c = xb_ld(&bar[XB_XCNT(j)]); sum += c; cnt += (c > 0u) ? 1u : 0u; mine = (j == x) ? c : mine; }
        if (sum == G) break;
        __builtin_amdgcn_s_sleep(1);
        if ((++sp & 255u) == 0u) { if (xb_ld(&bar[XB_TMO])) break; if (sp > XB_SPIN_CAP) { atomicAdd(&bar[XB_TMO], 1u); break; } }
    }
    nloc = mine > 0u ? mine : 1u; nx = cnt > 0u ? cnt : 1u;
}
__device__ __forceinline__ void xcd_barrier(unsigned* bar, unsigned x, volatile LAS unsigned* st, const int wave, const int lane) {
    asm volatile("s_waitcnt vmcnt(0)" ::: "memory");
    __syncthreads();
    if (wave == 0 && lane == 0) {
        __builtin_amdgcn_s_waitcnt(0);
        unsigned nloc = st[0], nx = st[1];
        if (nloc == 0u) { xcd_barrier_complete(bar, x, nloc, nx); st[0] = nloc; st[1] = nx; }
        const unsigned old = xb_add(&bar[XB_XSUB(x)], 1u);
        const unsigned gen = old / nloc;
        if (old + 1u == (gen + 1u) * nloc) {
            __builtin_amdgcn_fence(__ATOMIC_RELEASE, "agent");
            asm volatile("s_waitcnt vmcnt(0)" ::: "memory");
            const unsigned og = xb_add(&bar[XB_TOP], 1u);
            const unsigned tg = og / nx;
            if (og + 1u == (tg + 1u) * nx) xb_add(&bar[XB_TOPGEN], 1u);
            else XB_SPIN(xb_ld(&bar[XB_TOPGEN]) == tg, bar);
            __builtin_amdgcn_fence(__ATOMIC_ACQUIRE, "agent");
            xb_add(&bar[XB_XGEN(x)], 1u);
            asm volatile("s_waitcnt vmcnt(0)" ::: "memory");
        } else {
            XB_SPIN(xb_ld(&bar[XB_XGEN(x)]) == gen, bar);
            __builtin_amdgcn_fence(__ATOMIC_ACQUIRE, "agent");
            asm volatile("s_waitcnt vmcnt(0)" ::: "memory");
        }
    }
    __syncthreads();
}
constexpr int MISC_OFF = 147456 - 64;
constexpr size_t WS_BAR = 4096 * 4;
typedef const unsigned char __attribute__((address_space(4)))* kptr_t;
__device__ __forceinline__ kptr_t kargs() { kptr_t p = (kptr_t)__builtin_amdgcn_kernarg_segment_ptr(); asm volatile("" : "+s"(p)); return p; }
#define KIN(ka, i) (*(const float* const __attribute__((address_space(4)))*)((ka) + 8 * (i)))
#define KOUT(ka) (*(float* const __attribute__((address_space(4)))*)((ka) + 176))
#define KWS(ka) (*(unsigned char* const __attribute__((address_space(4)))*)((ka) + 184))
enum { I_XP = 0, I_XS, I_CCKV, I_CKPE, I_CBK, I_CBV, I_NMIX, I_WIN, I_GCQ, I_WUQ, I_GCKV, I_WUK, I_WUV, I_GQA, I_GKA, I_GQB, I_GKB, I_RELB, I_WO, I_NFFN, I_WUP, I_WDN };


constexpr int CW_SPLIT = 8192;
template <int S>
__device__ __forceinline__ void sample_split_unit(LAS unsigned char* lds, const bf16_t* A  , int lda, const bf16_t* Bt, int ldb, int N, int K, float* slab, unsigned* cnt, int vcu, int wave) {
    const int nN = N / 256, NSUB = 2 * nN * S, Ksub = K / S;
    if (vcu < NSUB) {
        const int ks = vcu % S, tile = vcu / S, pm = tile / nN, pn = tile % nN;
        pg8::Gemm g{A + (size_t)ks * Ksub, Bt + (size_t)ks * Ksub, 512, N, Ksub, lda, ldb}; pg8::OneUnit S1{pm, pn, true};
        pg8::EpiSlab E{slab + (size_t)ks * 2 * nN * 65536, nN}; pg8::gemm_phase(lds, g, S1, E, wave);
        asm volatile("s_waitcnt vmcnt(0)" ::: "memory");
        __syncthreads();
        if (wave == 0 && lane_now() == 0) (void)xb_add(cnt, 1u);
    }
}
__device__ __forceinline__ void sample_wait(unsigned* cnt, unsigned want, unsigned* tmo, int wave) {
    if (wave == 0) { if (lane_now() == 0) { XB_SPIN(xb_ld(cnt) < want, tmo - XB_TMO); } __builtin_amdgcn_fence(__ATOMIC_ACQUIRE, "agent"); asm volatile("s_waitcnt vmcnt(0)" ::: "memory"); }
    __syncthreads();
    __builtin_amdgcn_fence(__ATOMIC_ACQUIRE, "agent"); asm volatile("s_waitcnt vmcnt(0)" ::: "memory");
}
struct UpOrder { pg8::StaticOrder S; unsigned* cnt; unsigned* bar;
    __device__ bool next(int i, pg8::Unit& u) const { if (!S.next(i, u)) return false;
        if (u.pm >= MP / 256) { if (lane_now() == 0) { XB_SPIN(xb_ld(cnt) < 16u, bar); } __builtin_amdgcn_fence(__ATOMIC_ACQUIRE, "agent"); asm volatile("s_waitcnt vmcnt(0)" ::: "memory"); }
        return true; } };
template <int S>
__device__ __forceinline__ f32x4 slab_sum(const float* slab, int nN, int r, int c) {
    const float* p = slab + ((size_t)((r >> 8) * nN + (c >> 8)) * 256 + (r & 255)) * 256 + (c & 255);
    f32x4 s = *(const f32x4*)p;
#pragma unroll
    for (int k = 1; k < S; ++k) s += *(const f32x4*)(p + (size_t)k * 2 * nN * 65536);
    return s;
}
template <int S, class F>
__device__ __forceinline__ void sample_reduce(const float* slab, int N, unsigned* cnt, unsigned* bar, int vcu, int wave, const F& f) {
    sample_wait(cnt, (unsigned)(2 * (N / 256) * S), bar + XB_TMO, wave);
    const int lane = lane_now(), r = 2 * vcu + (wave >> 2);
    for (int c4 = lane; c4 < N / 16; c4 += 64) { const int c = (wave & 3) * (N / 4) + c4 * 4; f(r, c, slab_sum<S>(slab, N / 256, r, c)); }
}
struct RedBf16 { bf16_t* O; int ldc;
    __device__ __forceinline__ void operator()(int r, int c, f32x4 s) const { u32x2 w; w.x = cvtpk(s[0], s[1]); w.y = cvtpk(s[2], s[3]); *(u32x2*)(O + (size_t)r * ldc + c) = w; } };
struct RedRelu2 { bf16_t* O; int ldc;
    __device__ __forceinline__ void operator()(int r, int c, f32x4 s) const { float a[4];
#pragma unroll
        for (int e = 0; e < 4; ++e) { const float t = fmaxf(s[e], 0.f); a[e] = t * t; }
        u32x2 w; w.x = cvtpk(a[0], a[1]); w.y = cvtpk(a[2], a[3]); *(u32x2*)(O + (size_t)r * ldc + c) = w; } };
struct RedResBf16 { const float* base; bf16_t* out;
    __device__ __forceinline__ void operator()(int r, int c, f32x4 s) const { const f32x4 h = *(const f32x4*)(base + (size_t)r * DM + c) + s; u32x2 w; w.x = cvtpk(h[0], h[1]); w.y = cvtpk(h[2], h[3]); *(u32x2*)(out + (size_t)r * DM + c) = w; } };
struct RedResF32 { const float* base; float* out;
    __device__ __forceinline__ void operator()(int r, int c, f32x4 s) const { *(f32x4*)(out + (size_t)r * DM + c) = *(const f32x4*)(base + (size_t)r * DM + c) + s; } };

__global__ void __launch_bounds__(NWAVES * 64, 2) mk_fwd(Args args) {
    extern __shared__ __attribute__((aligned(16))) unsigned char lds_raw[];
    LAS unsigned char* lds = (LAS unsigned char*)lds_raw;
    cg::grid_group grid = cg::this_grid();
    const int wave = __builtin_amdgcn_readfirstlane((int)(threadIdx.x >> 6));
    const int G = gridDim.x, bx = blockIdx.x, vcu = (G % 8 == 0) ? (bx % 8) * (G / 8) + bx / 8 : bx;
    const int gw = vcu * NWAVES + wave, NGW = G * NWAVES;
    volatile LAS unsigned* xst = (volatile LAS unsigned*)(lds + MISC_OFF);
    { const int lane = lane_now(); if (wave == 0 && lane < 2) xst[lane] = 0u;
      if (bx == 0) { unsigned* bw = (unsigned*)(KWS(kargs()) + WS_BAR); for (int i = wave * 64 + lane; i < XCD_BAR_WORDS; i += NWAVES * 64) bw[i] = 0u;
                     if (wave == 0 && lane < 5) ((unsigned*)KWS(kargs()))[CW_SPLIT + 64 * lane] = 0u; } }
    const unsigned xcc = xb_xcc_id();

    REP(1) if (PH & 1) {
        kptr_t ka = kargs(); unsigned char* ws = KWS(ka); const int lane = lane_now();
        LAS float* scr = (LAS float*)(lds + wave * 16384);
        bf16_t* WIN = (bf16_t*)(ws + WS_WIN);
        constexpr int I_IN = (DM / 64) * (NCP / 32);
        constexpr int I_WIDE = (DM / 128) * (CC_KPE / 64), I_REST = (DM / 64) * ((NCP - CC_KPE) / 32);
        for (int it = gw; it < I_WIDE + I_REST; it += NGW) {
            if (it < I_WIDE) { const int nb = it % (CC_KPE / 64), kb = it / (CC_KPE / 64), n0 = nb * 64;
                transpose_wide(KIN(ka, I_WIN) + (n0 < CC_QB ? 0 : 64), INC, n0, WIN, DM, kb * 128, lds + wave * 16384, lane); }
            else { const int r = it - I_WIDE, nb = r % ((NCP - CC_KPE) / 32), kb = r / ((NCP - CC_KPE) / 32), n0 = CC_KPE + nb * 32;
                const bool isk = n0 < CC_KPE + 64;
                transpose_item(KIN(ka, I_WIN), INC, isk ? 768 : -1, WIN, DM, n0, kb * 64, scr, lane, nullptr, isk ? (n0 - CC_KPE) / 32 : -1); } }
        { bf16_t* XN = (bf16_t*)(ws + WS_XN); const float* xp = KIN(ka, I_XP); const float* xs = KIN(ka, I_XS); const float* nm = KIN(ka, I_NMIX);
          RowPtrX rp{xp, xs}; rms_pass_2048(rp, MT, nm, XN, gw, NGW, lane); }
        { float* ROPET = (float*)(ws + WS_ROPE);
          for (int i = gw * 64 + lane; i < SEQ * 32; i += NGW * 64) { const int pos = i >> 5, k = i & 31;
            const float inv = 1.0f / powf(10000.0f, (float)(2 * k) / 64.0f); const float ang = (float)pos * inv;
            const double a = (double)ang; ROPET[(size_t)pos * 64 + k] = (float)cos(a); ROPET[(size_t)pos * 64 + 32 + k] = (float)sin(a); } }
    }
    grid.sync();
    { unsigned* bw_ = (unsigned*)(KWS(kargs()) + WS_BAR); if (wave == 0 && lane_now() == 0) (void)xb_add(&bw_[XB_XCNT(xcc)], 1u); }
    REP(2) if (PH & 2) {
      if (SPLIT_IN) { kptr_t ka = kargs(); unsigned char* ws = KWS(ka);
        sample_split_unit<8>(lds, (const bf16_t*)(ws + WS_XN) + (size_t)MP * DM, DM, (const bf16_t*)(ws + WS_WIN), DM, NCP, DM, (float*)(ws + WS_SLAB1), (unsigned*)ws + CW_SPLIT + 64 * 0, vcu, wave); }
      { kptr_t ka = kargs(); unsigned char* ws = KWS(ka);
        pg8::Gemm g{(const bf16_t*)(ws + WS_XN), (const bf16_t*)(ws + WS_WIN), MP, NCP, DM, DM, DM}; pg8::StaticOrder S; S.init(SPLIT_IN ? MP : MT, NCP, G, bx);
        pg8::EpiInproj E{(bf16_t*)((unsigned char*)KOUT(ka) + OS_C2), (bf16_t*)(ws + WS_QB), (bf16_t*)(ws + WS_KBP), (bf16_t*)(ws + WS_KBS), (bf16_t*)(ws + WS_VBP), (bf16_t*)(ws + WS_VBS), KOUT(ka), KIN(ka, I_GQB), KIN(ka, I_GKB), KIN(ka, I_GCKV), (bf16_t*)(ws + WS_CKV), (float*)(ws + WS_PCQ), KIN(ka, I_GKA), (const float*)(ws + WS_ROPE), (float*)((unsigned char*)KOUT(ka) + OS_R), (float*)((unsigned char*)KOUT(ka) + OS_SSPE), lds + 131072}; pg8::gemm_phase(lds, g, S, E, wave); }
      { const int nwg_ = ((SPLIT_IN ? MP : MT) / 256) * (NCP / 256), ntail = nwg_ % G;
        if (ntail > 0 && bx >= ntail) {
          kptr_t ka = kargs(); unsigned char* ws = KWS(ka); unsigned char* os = (unsigned char*)KOUT(ka); const int lane = lane_now();
          const int gwx = (bx - ntail) * NWAVES + wave, NGWX = (G - ntail) * NWAVES;
          LAS float* scr = (LAS float*)(lds + wave * 16384);
          bf16_t* WUQ = (bf16_t*)(ws + WS_WUQ); bf16_t* WUKV = (bf16_t*)(ws + WS_WUKV); bf16_t* WO = (bf16_t*)(ws + WS_WO);
          constexpr int I_UQ = (QLORA / 64) * (2048 / 32), I_UK = (KVLORA / 64) * (1024 / 32), I_UV = I_UK, I_O = (DM / 64) * (DM / 32);
          constexpr int NITEMS = I_UQ + I_UK + I_UV;
          for (int it = gwx; it < NITEMS; it += NGWX) {
            int r = it;
            if (r < I_UQ) { const int nb = r % 64, kb = r / 64, h = nb >> 3, b8 = nb & 7;
                const int col0 = b8 < 4 ? h * QKA + b8 * 32 : (b8 < 6 ? h * QKA + NOPE : -1);
                transpose_item(KIN(ka, I_WUQ), 1536, col0, WUQ, QLORA, nb * 32, kb * 64, scr, lane, KIN(ka, I_GCQ), (b8 == 4 || b8 == 5) ? b8 - 4 : -1); continue; } r -= I_UQ;
            if (r < I_UK) { const int nb = r % 32, kb = r / 32; transpose_item(KIN(ka, I_WUK), 1024, nb * 32, WUKV, KVLORA, nb * 32, kb * 64, scr, lane); continue; } r -= I_UK;
            if (r < I_UV) { const int nb = r % 32, kb = r / 32; transpose_item(KIN(ka, I_WUV), 1024, nb * 32, WUKV, KVLORA, 1024 + nb * 32, kb * 64, scr, lane); continue; } r -= I_UV;
            { const int r2 = r; (void)r2; }
          }
          for (int it = gwx; it < (DM / 128) * (DM / 64); it += NGWX) { const int nb = it % (DM / 64), kb = it / (DM / 64);
            transpose_wide(KIN(ka, I_WO), DM, nb * 64, WO, DM, kb * 128, lds + wave * 16384, lane); }
          const int gw = gwx, NGW = NGWX;
          { bf16_t* CKV = (bf16_t*)(ws + WS_CKV); const float* cc = KIN(ka, I_CCKV);
            for (int rr = gw; rr < DECB * PAST; rr += NGW) { const int s = rr / PAST, p = rr % PAST; const f32x4 v = *((const f32x4*)(cc + (size_t)rr * KVLORA) + lane);
              u32x2 w; w.x = cvtpk(v.x, v.y); w.y = cvtpk(v.z, v.w); *((u32x2*)(CKV + (size_t)(MP + s * KVLEN + p) * KVLORA) + lane) = w; } }
          { bf16_t* KBS = (bf16_t*)(ws + WS_KBS); bf16_t* VBS = (bf16_t*)(ws + WS_VBS); const float* cbk = KIN(ka, I_CBK); const float* cbv = KIN(ka, I_CBV);
            for (int rr = gw; rr < DECB * BANDL; rr += NGW) { const int s = rr / BANDL, p = rr % BANDL; const size_t dst = (size_t)(s * BLEN + p) * 1024;
#pragma unroll
              for (int j = 0; j < 4; ++j) { const f32x4 a = *((const f32x4*)(cbk + (size_t)rr * 1024) + lane + 64 * j), b = *((const f32x4*)(cbv + (size_t)rr * 1024) + lane + 64 * j);
                  u32x2 wa, wb; wa.x = cvtpk(a.x, a.y); wa.y = cvtpk(a.z, a.w); wb.x = cvtpk(b.x, b.y); wb.y = cvtpk(b.z, b.w);
                  *((u32x2*)(KBS + dst) + lane + 64 * j) = wa; *((u32x2*)(VBS + dst) + lane + 64 * j) = wb; } } }

          { const float* ROPET = (const float*)(ws + WS_ROPE); float* R = (float*)(os + OS_R); float* SSPE = (float*)(os + OS_SSPE); const float* ck = KIN(ka, I_CKPE); const float* gka = KIN(ka, I_GKA);
            for (int it = gw; it < DECB * PAST / 8; it += NGW) { const int rr = it * 8 + (lane >> 3), c8 = lane & 7, s = rr / PAST, p = rr % PAST;
              const float* src = ck + (size_t)rr * ROPE + 8 * c8; const f32x4 a = *(const f32x4*)src, b = *(const f32x4*)(src + 4);
              const float v[8] = {a.x, a.y, a.z, a.w, b.x, b.y, b.z, b.w};
              kpe_item(v, c8, MP + s * KVLEN + p, p, true, gka, ROPET, R, SSPE); } }
        } }
      if (SPLIT_IN) { kptr_t ka = kargs(); unsigned char* ws = KWS(ka);
        RedBf16 f{(bf16_t*)(ws + WS_C) + (size_t)MP * NCP, NCP};
        sample_reduce<8>((const float*)(ws + WS_SLAB1), NCP, (unsigned*)ws + CW_SPLIT + 64 * 0, (unsigned*)(ws + WS_BAR), vcu, wave, f); }
    }
    GSYNC();

    REP(8) if (PH & 8) { kptr_t ka = kargs(); unsigned char* ws = KWS(ka); unsigned char* os = (unsigned char*)KOUT(ka);
      pg8::Gemm g{(const bf16_t*)(os + OS_C2), (const bf16_t*)(ws + WS_WUQ), MT, 2048, QLORA, CP, QLORA}; pg8::StaticOrder S; S.init(MT, 2048, G, bx);
      pg8::EpiQ E{(bf16_t*)(ws + WS_Q), (const float*)(ws + WS_PCQ), KIN(ka, I_GQA), (const float*)(ws + WS_ROPE), lds + 131072}; pg8::gemm_phase(lds, g, S, E, wave); }
    REP(1024) if (PH & 8) { kptr_t ka = kargs(); unsigned char* ws = KWS(ka);
      pg8::Gemm g{(const bf16_t*)(ws + WS_CKV), (const bf16_t*)(ws + WS_WUKV), KVROWS, 2048, KVLORA, KVLORA, KVLORA}; pg8::StaticOrder S; S.init(KVROWS, 2048, G, G - 1 - bx);
      unsigned char* os = (unsigned char*)KOUT(ka);
      pg8::EpiKV E{os, ws, KIN(ka, I_GKA), lds + 131072}; pg8::gemm_phase(lds, g, S, E, wave); }
    GSYNC();

    REP(32) if ((PH & 32) && G == 256) {
        att::UnitDesc u; const int lane = lane_now();
        for (int k = 0; k < 2; ++k) { kptr_t ka = kargs(); unsigned char* ws = KWS(ka); unsigned char* os = (unsigned char*)KOUT(ka);
            const bf16_t* Q = (const bf16_t*)(ws + WS_Q); const bf16_t* KM = (const bf16_t*)(os + OS_K); const bf16_t* VM = (const bf16_t*)(ws + WS_XN); bf16_t* AO = (bf16_t*)(ws + WS_AO);
            const int bh = vcu >> 4, b = bh >> 3, h = bh & 7, s = vcu & 15;
            const int qb = k == 0 ? 31 - s : s; const size_t row0 = (size_t)b * SEQ + qb * 256;
            u.Q = Q + row0 * 1536 + h * QKA; u.ldq = 1536; u.K = KM + (size_t)b * SEQ * 1536 + h * QKA; u.ldk = 1536; u.V = VM + (size_t)b * SEQ * 1024 + h * VA; u.ldv = 1024;
            u.O = AO + row0 * DM + h * VA; u.ldo = DM; u.t0 = 0; u.t1 = 4 * qb + 4; u.wlo = 0; u.whi = 4 * qb + (wave >> 1); u.half_last = 0; u.rb0 = 0; u.rbstep = 0; u.qi = 0;
            att::attn_unit<192, false>(u, lds, nullptr, wave); }
        for (int k = 0; k < 2; ++k) { kptr_t ka = kargs(); unsigned char* ws = KWS(ka);
            const bf16_t* QB = (const bf16_t*)(ws + WS_QB); const bf16_t* KBP = (const bf16_t*)(ws + WS_KBP); const bf16_t* VBP = (const bf16_t*)(ws + WS_VBP); bf16_t* AO = (bf16_t*)(ws + WS_AO);
            const int id = 2 * vcu + k, qb = id & 31, hh = (id >> 5) & 7, bb = id >> 8; const size_t row0 = (size_t)bb * SEQ + qb * 256;
            const int cq = 4 * qb + (wave >> 1);
            u.Q = QB + row0 * 1024 + hh * DHB; u.ldq = 1024; u.K = KBP + (size_t)bb * SEQ * 1024 + hh * DHB; u.ldk = 1024; u.V = VBP + (size_t)bb * SEQ * 1024 + hh * DHB; u.ldv = 1024;
            u.O = AO + row0 * DM + 1024 + hh * DHB; u.ldo = DM; u.t0 = max(0, 4 * qb - 8); u.t1 = 4 * qb + 4; u.wlo = max(0, cq - 8); u.whi = cq; u.half_last = 0;
            u.rb0 = 64 * cq; u.rbstep = -64; u.qi = 32 * (wave & 1) + (lane & 31);
            att::attn_unit<128, true>(u, lds, KIN(ka, I_RELB) + hh * NREL, wave); }
        if (vcu < 128) { kptr_t ka = kargs(); unsigned char* ws = KWS(ka); unsigned char* os = (unsigned char*)KOUT(ka);
            const bf16_t* Q = (const bf16_t*)(ws + WS_Q); const bf16_t* KM = (const bf16_t*)(os + OS_K); const bf16_t* VM = (const bf16_t*)(ws + WS_XN); bf16_t* AO = (bf16_t*)(ws + WS_AO);
            const int s = vcu >> 3, h = vcu & 7; const size_t row0 = (size_t)MP + s * DECS;
            u.Q = Q + row0 * 1536 + h * QKA; u.ldq = 1536; u.K = KM + (size_t)(MP + s * KVLEN) * 1536 + h * QKA; u.ldk = 1536; u.V = VM + (size_t)(MP + s * KVLEN) * 1024 + h * VA; u.ldv = 1024;
            u.O = (bf16_t*)(ws + WS_AOS) + (row0 - MP) * DM + h * VA; u.ldo = DM; u.t0 = 0; u.t1 = 17; u.wlo = wave == 0 ? 0 : 1; u.whi = wave == 0 ? 16 : 0; u.half_last = 1; u.rb0 = 0; u.rbstep = 0; u.qi = 0;
            att::attn_unit_ks<192, false>(u, lds, nullptr, wave);
        } else { kptr_t ka = kargs(); unsigned char* ws = KWS(ka);
            const bf16_t* QB = (const bf16_t*)(ws + WS_QB); const bf16_t* KBS = (const bf16_t*)(ws + WS_KBS); const bf16_t* VBS = (const bf16_t*)(ws + WS_VBS); bf16_t* AO = (bf16_t*)(ws + WS_AO);
            const int s = (vcu - 128) >> 3, h = vcu & 7; const size_t row0 = (size_t)MP + s * DECS;
            u.Q = QB + row0 * 1024 + h * DHB; u.ldq = 1024; u.K = KBS + (size_t)(s * BLEN) * 1024 + h * DHB; u.ldk = 1024; u.V = VBS + (size_t)(s * BLEN) * 1024 + h * DHB; u.ldv = 1024;
            u.O = (bf16_t*)(ws + WS_AOS) + (row0 - MP) * DM + 1024 + h * DHB; u.ldo = DM; u.t0 = 0; u.t1 = 9; u.wlo = wave == 0 ? 0 : 1; u.whi = wave == 0 ? 8 : 0; u.half_last = 1;
            u.rb0 = BANDL; u.rbstep = -64; u.qi = lane & 31;
            att::attn_unit_ks<128, true>(u, lds, KIN(ka, I_RELB) + h * NREL, wave); }
    }
    GSYNC();

    REP(64) if (PH & 64) {
      if (SPLIT_WO) { kptr_t ka = kargs(); unsigned char* ws = KWS(ka);
        sample_split_unit<8>(lds, (const bf16_t*)(ws + WS_AO) + (size_t)MP * DM, DM, (const bf16_t*)(ws + WS_WO), DM, DM, DM, (float*)(ws + WS_SLAB4), (unsigned*)ws + CW_SPLIT + 64 * 1, vcu, wave); }
      { kptr_t ka = kargs(); unsigned char* ws = KWS(ka);
        pg8::Gemm g{(const bf16_t*)(ws + WS_AO), (const bf16_t*)(ws + WS_WO), MP, DM, DM, DM, DM}; pg8::StaticOrder S; S.init(MP, DM, G, bx);
        pg8::EpiResBf16 E{KIN(ka, I_XP), nullptr, (bf16_t*)(ws + WS_HB), (float*)(ws + WS_SSP)}; pg8::gemm_phase(lds, g, S, E, wave); }
      { kptr_t ka = kargs(); unsigned char* ws = KWS(ka); const int lane = lane_now(); bf16_t* WUP = (bf16_t*)(ws + WS_WUP);
        __syncthreads();
        for (int r = bx * NWAVES + wave; r < (DM / 128) * (DFF / 64); r += G * NWAVES) { const int nb = r % (DFF / 64), kb = r / (DFF / 64); transpose_wide(KIN(ka, I_WUP), DFF, nb * 64, WUP, DM, kb * 128, lds + wave * 16384, lane, KIN(ka, I_NFFN)); } }
      if (SPLIT_WO) { kptr_t ka = kargs(); unsigned char* ws = KWS(ka);
        RedResBf16 f{KIN(ka, I_XS), (bf16_t*)(ws + WS_HB) + (size_t)MP * DM};
        sample_reduce<8>((const float*)(ws + WS_SLAB4), DM, (unsigned*)ws + CW_SPLIT + 64 * 1, (unsigned*)(ws + WS_BAR), vcu, wave, f); }
    }
    GSYNC();
    { kptr_t ka = kargs(); unsigned char* ws = KWS(ka); const int lane = lane_now(); const float* PHs = (const float*)(ws + WS_SSP); float* RS2 = (float*)(ws + WS_SSP + 3 * MiB);
      for (int r = gw * 64 + lane; r < MP; r += NGW * 64) { float s = 0.f;
#pragma unroll
        for (int j = 0; j < 8; ++j) { const f32x4 p = *(const f32x4*)(PHs + (size_t)r * 32 + 4 * j); s += (p[0] + p[1]) + (p[2] + p[3]); }
        RS2[r] = 1.0f / (s * (1.f / 2048.f) + EPS); } }
    REP(256) if (PH & 256) {
      if (SPLIT_UP) { kptr_t ka = kargs(); unsigned char* ws = KWS(ka);
        sample_split_unit<4>(lds, (const bf16_t*)(ws + WS_XN) + (size_t)MP * DM, DM, (const bf16_t*)(ws + WS_WUP), DM, DFF, DM, (float*)(ws + WS_SLAB), (unsigned*)ws + CW_SPLIT + 64 * 2, vcu, wave); }
      if (bx >= 64 && bx < 80) { kptr_t ka = kargs(); unsigned char* ws = KWS(ka);
        const int j = bx - 64; pg8::Gemm g{(const bf16_t*)(ws + WS_AOS) - (size_t)MP * DM, (const bf16_t*)(ws + WS_WO), MT, DM, DM, DM, DM};   pg8::OneUnit S1{MP / 256 + (j >> 3), j & 7, true};
        pg8::EpiResBf16 E{KIN(ka, I_XP), KIN(ka, I_XS), (bf16_t*)(ws + WS_HB), (float*)(ws + WS_SSP)}; pg8::gemm_phase(lds, g, S1, E, wave);
        asm volatile("s_waitcnt vmcnt(0)" ::: "memory");
        __syncthreads();
        if (wave == 0 && lane_now() == 0) { __builtin_amdgcn_fence(__ATOMIC_RELEASE, "agent"); asm volatile("s_waitcnt vmcnt(0)" ::: "memory"); (void)xb_add((unsigned*)ws + CW_SPLIT + 64 * 4, 1u); }
        __syncthreads(); }
      { kptr_t ka = kargs(); unsigned char* ws = KWS(ka);
        pg8::Gemm g{(const bf16_t*)(ws + WS_HB), (const bf16_t*)(ws + WS_WUP), MP, DFF, DM, DM, DM}; UpOrder S; S.S.init(MT, DFF, G, bx); S.cnt = (unsigned*)ws + CW_SPLIT + 64 * 4; S.bar = (unsigned*)(ws + WS_BAR);
        pg8::EpiBf16<1> E{(bf16_t*)(ws + WS_U), PU, 0, 0}; pg8::gemm_phase(lds, g, S, E, wave); }
      { const int ntail = 80;
        if (bx >= ntail) { kptr_t ka = kargs(); unsigned char* ws = KWS(ka); const int lane = lane_now(); LAS float* scr = (LAS float*)(lds + wave * 16384); bf16_t* WDN = (bf16_t*)(ws + WS_WDN);
          for (int r = (bx - ntail) * NWAVES + wave; r < (DFF / 128) * (DM / 64); r += (G - ntail) * NWAVES) { const int nb = r % (DM / 64), kb = r / (DM / 64); transpose_wide(KIN(ka, I_WDN), DM, nb * 64, WDN, PU, kb * 128, lds + wave * 16384, lane); } } }
      if (SPLIT_UP) { kptr_t ka = kargs(); unsigned char* ws = KWS(ka);
        RedRelu2 f{(bf16_t*)(ws + WS_U) + (size_t)MP * PU, PU};
        sample_reduce<4>((const float*)(ws + WS_SLAB), DFF, (unsigned*)ws + CW_SPLIT + 64 * 2, (unsigned*)(ws + WS_BAR), vcu, wave, f); }
    }
    GSYNC();
    if (PH & 512) {
      { kptr_t ka = kargs(); unsigned char* ws = KWS(ka);
        sample_split_unit<16>(lds, (const bf16_t*)(ws + WS_U) + (size_t)MP * PU, PU, (const bf16_t*)(ws + WS_WDN), PU, DM, DFF, (float*)(ws + WS_SLAB), (unsigned*)ws + CW_SPLIT + 64 * 3, vcu, wave); }
#if (DBL) & 512
      { kptr_t ka = kargs(); unsigned char* ws = KWS(ka);
        pg8::Gemm g{(const bf16_t*)(ws + WS_U), (const bf16_t*)(ws + WS_WDN), MP, DM, DFF, PU, PU}; pg8::StaticOrder S; S.init(MP, DM, G, bx);
        pg8::EpiSlab E{(float*)(ws + WS_XN) + (size_t)bx * 65536, 0}; pg8::gemm_phase(lds, g, S, E, wave); }
#endif
      { kptr_t ka = kargs(); unsigned char* ws = KWS(ka); float* Y = KOUT(ka) + O_Y;
        pg8::Gemm g{(const bf16_t*)(ws + WS_U), (const bf16_t*)(ws + WS_WDN), MP, DM, DFF, PU, PU}; pg8::StaticOrder S; S.init(MP, DM, G, bx);
        pg8::EpiAddBf16 E{(const bf16_t*)(ws + WS_HB), Y, (const float*)(ws + WS_SSP + 3 * MiB)}; pg8::gemm_phase(lds, g, S, E, wave); }
      { kptr_t ka = kargs(); unsigned char* ws = KWS(ka); float* Y = KOUT(ka) + O_Y + (size_t)MP * DM; const float* slab = (const float*)(ws + WS_SLAB); const int lane = lane_now();
        sample_wait((unsigned*)ws + CW_SPLIT + 64 * 3, 2 * (DM / 256) * 16, (unsigned*)(ws + WS_BAR) + XB_TMO, wave);
        const int r = 2 * vcu + (wave >> 2); float rs2;
        { const float* PHs = (const float*)(ws + WS_SSP) + (size_t)(MP + r) * 32; float sq = 0.f;
#pragma unroll
          for (int jj = 0; jj < 8; ++jj) { const f32x4 pv = *(const f32x4*)(PHs + 4 * jj); sq += (pv[0] + pv[1]) + (pv[2] + pv[3]); }
          rs2 = 1.0f / (sq * (1.f / 2048.f) + EPS); }
        const bf16_t* hbs = (const bf16_t*)(ws + WS_HB) + (size_t)MP * DM;
        for (int c4 = lane; c4 < DM / 16; c4 += 64) { const int c = (wave & 3) * (DM / 4) + c4 * 4; const u32x2 hw = *(const u32x2*)(hbs + (size_t)r * DM + c); const f32x4 h = {bflo(hw.x), bfhi(hw.x), bflo(hw.y), bfhi(hw.y)};
            *(f32x4*)(Y + (size_t)r * DM + c) = h + slab_sum<16>(slab, DM / 256, r, c) * rs2; } }
    }
}

extern "C" void kernel_launch(void* const* d_in, const int* in_sizes, int n_in, void* d_out, int out_size, void* d_ws, size_t ws_size, hipStream_t stream) {
    static int grid = 0;
    if (grid == 0) {
        if (n_in != 22 || out_size != (int)O_END || ws_size < WS_NEED) { fprintf(stderr, "kernel_launch: unexpected shapes: n_in %d out %d ws %zu\n", n_in, out_size, ws_size); grid = -1; return; }
        int dev = 0, cus = 0, per_cu = 0;
        if (hipGetDevice(&dev) != hipSuccess || hipDeviceGetAttribute(&cus, hipDeviceAttributeMultiprocessorCount, dev) != hipSuccess) { grid = -1; return; }
        if (hipFuncSetAttribute((const void*)mk_fwd, hipFuncAttributeMaxDynamicSharedMemorySize, LDS_BYTES) != hipSuccess) { fprintf(stderr, "hipFuncSetAttribute failed\n"); grid = -1; return; }
        if (hipOccupancyMaxActiveBlocksPerMultiprocessor(&per_cu, (const void*)mk_fwd, NWAVES * 64, LDS_BYTES) != hipSuccess || per_cu < 1) { fprintf(stderr, "occupancy query: %d\n", per_cu); }
        (void)hipGetLastError();
        grid = cus;
        if (grid != 256) fprintf(stderr, "kernel_launch: %d CUs (built for 256)\n", grid);
    }
    if (grid < 0) return;
    Args a{};
    for (int i = 0; i < 22; ++i) a.in[i] = (const float*)d_in[i];
    a.out = (float*)d_out; a.ws = (unsigned char*)d_ws;
    void* args[] = {&a};
    hipError_t e = hipLaunchCooperativeKernel((const void*)mk_fwd, dim3(grid), dim3(NWAVES * 64), args, LDS_BYTES, stream);
    if (e != hipSuccess) fprintf(stderr, "cooperative launch failed: %s\n", hipGetErrorString(e));
}
```
